# Optimizing an MI355X kernel written in HIP

```python
import jax, jax.numpy as jnp
from jax import lax
import numpy as np

D_MODEL = 2048
BATCH = 4
SEQ = 8192
DEPTH = 1

GRID_W = 64
CTX_LEN = 256
RMS_EPS = 1e-6
N_MOD = 6
MLA_HEADS = 8
Q_LORA = 512
KV_LORA = 256
QK_NOPE = 128
QK_ROPE = 64
V_HEAD = 128
MLA_WIDTH = MLA_HEADS * V_HEAD
ROPE_THETA = 10000.0
Q_BLOCK = 128
HG_HEADS = 8
HG_FDIM = 128
HG_IDIM = 128
HG_FW = HG_HEADS * HG_FDIM
HG_IW = HG_HEADS * HG_IDIM
HG_CHUNK = 64
D_FF = -(-(8 * D_MODEL) // (3 * 256)) * 256
IN_WIDTHS = (Q_LORA, KV_LORA, QK_ROPE, HG_FW, HG_FW, HG_FW, HG_IW, HG_IW, 2 * D_MODEL)
N_IN = sum(IN_WIDTHS)

kernel_name = "hybrid_mla_hgrn2_dit_block"


def rmsnorm(x, g):
    xf = x.astype(jnp.float32)
    y = xf * lax.rsqrt(jnp.mean(xf * xf, axis=-1, keepdims=True) + RMS_EPS)
    return (y * g.astype(jnp.float32)).astype(x.dtype)


def modulate(h, shift, scale):
    return h * (1 + scale) + shift


def axial_rope_tables(rows):
    pairs = QK_ROPE // 4
    row = jnp.repeat(jnp.arange(rows, dtype=jnp.float32), GRID_W)
    col = jnp.tile(jnp.arange(GRID_W, dtype=jnp.float32), rows)
    inv = ROPE_THETA ** (-jnp.arange(pairs, dtype=jnp.float32) / pairs)
    ang = jnp.concatenate([row[:, None] * inv, col[:, None] * inv], axis=-1)
    return jnp.cos(ang)[:, None, :], jnp.sin(ang)[:, None, :]


def apply_rope(x, cos, sin):
    half = QK_ROPE // 2
    xf = x.astype(jnp.float32)
    x1, x2 = xf[..., :half], xf[..., half:]
    out = jnp.concatenate([x1 * cos - x2 * sin, x2 * cos + x1 * sin], axis=-1)
    return out.astype(x.dtype)


def forget_gate(f_logit, lb):
    f = lb + (1.0 - lb) * jax.nn.sigmoid(f_logit.astype(jnp.float32))
    return 1.0 - f, jnp.log(f)


def mixer_projections(h, w_in_l, q_norm_g, kv_norm_g, w_uq_l, w_ukv_l, lb_l, rope):
    bsz, length, _ = h.shape
    p = h @ w_in_l
    c_q, c_kv, k_r, hg_q, hg_ff, hg_fb, hg_i, hg_g, gate_logits = jnp.split(
        p, np.cumsum(IN_WIDTHS)[:-1].tolist(), axis=-1)
    q = (rmsnorm(c_q, q_norm_g) @ w_uq_l).reshape(bsz, length, MLA_HEADS, QK_NOPE + QK_ROPE)
    kv = (rmsnorm(c_kv, kv_norm_g) @ w_ukv_l).reshape(bsz, length, MLA_HEADS, QK_NOPE + V_HEAD)
    q_nope, q_rope = q[..., :QK_NOPE], q[..., QK_NOPE:]
    k_nope, v = kv[..., :QK_NOPE], kv[..., QK_NOPE:]
    k_rope = k_r[:, :, None, :]
    if rope is not None:
        cos, sin = rope
        q_rope = apply_rope(q_rope, cos, sin)
        k_rope = apply_rope(k_rope, cos, sin)
    q = jnp.concatenate([q_nope, q_rope], axis=-1)
    k = jnp.concatenate([k_nope, jnp.broadcast_to(k_rope, (bsz, length, MLA_HEADS, QK_ROPE))], axis=-1)
    heads = lambda t: t.reshape(bsz, length, HG_HEADS, -1)
    hq = heads(jax.nn.silu(hg_q)) * (HG_FDIM ** -0.5)
    k_f, lf_f = forget_gate(heads(hg_ff), lb_l[0])
    k_b, lf_b = forget_gate(heads(hg_fb), lb_l[1])
    hv = heads(hg_i)
    hgate = heads(hg_g)
    return (q, k, v), (hq, k_f, lf_f, k_b, lf_b, hv, hgate), gate_logits.reshape(bsz, length, 2, D_MODEL)


def block_attention(q, k, v):
    bsz, length, nh, dqk = q.shape
    nb = length // Q_BLOCK
    scale = dqk ** -0.5
    qb = q.reshape(bsz, nb, Q_BLOCK, nh, dqk).swapaxes(0, 1)

    def one_block(qblk):
        s = jnp.einsum('bqhd,bkhd->bhqk', qblk, k).astype(jnp.float32) * scale
        p = jax.nn.softmax(s, axis=-1)
        return jnp.einsum('bhqk,bkhv->bqhv', p.astype(v.dtype), v)

    out = lax.map(one_block, qb)
    return out.swapaxes(0, 1).reshape(bsz, length, nh, v.shape[-1])


def gla_chunkwise(q, k, v, log_f, s0):
    out_dtype = v.dtype
    bsz, length, nh, dk = q.shape
    dv = v.shape[-1]
    n = length // HG_CHUNK
    q, k, v, log_f = [t.astype(jnp.float32).reshape(bsz, n, HG_CHUNK, nh, -1) for t in (q, k, v, log_f)]
    b = jnp.cumsum(log_f, axis=2)
    b_last = b[:, :, -1]
    q_d = q * jnp.exp(b)
    k_d = k * jnp.exp(-b)
    k_tail = k * jnp.exp(b_last[:, :, None] - b)
    mask = jnp.tril(jnp.ones((HG_CHUNK, HG_CHUNK), dtype=bool))
    scores = jnp.where(mask, jnp.einsum('bnthd,bnshd->bnhts', q_d, k_d), 0.0)
    o_intra = jnp.einsum('bnhts,bnshv->bnthv', scores, v)
    u = jnp.einsum('bnshd,bnshv->bnhdv', k_tail, v)
    decay = jnp.exp(b_last)

    def step(s, inp):
        d, u_j = inp
        return d[..., None] * s + u_j, s

    s_final, s_starts = lax.scan(step, s0.astype(jnp.float32),
                                 (jnp.moveaxis(decay, 1, 0), jnp.moveaxis(u, 1, 0)))
    s_starts = jnp.moveaxis(s_starts, 0, 1)
    o_inter = jnp.einsum('bnthd,bnhdv->bnthv', q_d, s_starts)
    o = (o_intra + o_inter).reshape(bsz, length, nh, dv)
    return o.astype(out_dtype), s_final


def hgrn2_bidirectional(hq, k_f, lf_f, k_b, lf_b, hv, s_f0, s_b0):
    o_f, s_f = gla_chunkwise(hq, k_f, hv, lf_f, s_f0)
    rev = lambda t: jnp.flip(t, axis=1)
    o_b, s_b = gla_chunkwise(rev(hq), rev(k_b), rev(hv), rev(lf_b), s_b0)
    return o_f + rev(o_b), s_f, s_b


def merge_branches(attn_o, hg_o, hgate, gate_logits, o_norm_g, w_br_mla_l, w_br_hgrn_l, w_out_l):
    bsz, length = attn_o.shape[:2]
    hg_o = rmsnorm(hg_o, o_norm_g) * jax.nn.silu(hgate)
    y_a = attn_o.reshape(bsz, length, MLA_WIDTH) @ w_br_mla_l
    y_h = hg_o.reshape(bsz, length, HG_IW) @ w_br_hgrn_l
    g = jax.nn.sigmoid(gate_logits)
    return (g[..., 0, :] * y_a + g[..., 1, :] * y_h) @ w_out_l


def swiglu(h, w_in_l, w_out_l):
    a, b = jnp.split(h @ w_in_l, 2, axis=-1)
    return (jax.nn.silu(a) * b) @ w_out_l


def setup_inputs(seed: int = 0) -> dict:
    key = jax.random.key(seed)
    ks = jax.random.split(key, 19)
    f32 = jnp.float32
    nrm = lambda k, shape, fan_in: jax.random.normal(k, shape, f32) * (fan_in ** -0.5)
    gain = lambda k, shape: 1.0 + 0.05 * jax.random.normal(k, shape, f32)
    return {
        "x": jax.random.normal(ks[0], (BATCH, SEQ, D_MODEL), f32),
        "c": jax.random.normal(ks[1], (BATCH, D_MODEL), f32),
        "ctx": jax.random.normal(ks[2], (BATCH, CTX_LEN, D_MODEL), f32),
        "c_ctx": jax.random.normal(ks[3], (D_MODEL,), f32),
        "w_mod": nrm(ks[4], (DEPTH, D_MODEL, N_MOD * D_MODEL), D_MODEL),
        "b_mod": 0.02 * jax.random.normal(ks[5], (DEPTH, N_MOD * D_MODEL), f32),
        "norm_g": gain(ks[6], (DEPTH, 4, D_MODEL)),
        "w_in": nrm(ks[7], (DEPTH, D_MODEL, N_IN), D_MODEL),
        "mla_q_norm": gain(ks[8], (DEPTH, Q_LORA)),
        "mla_kv_norm": gain(ks[9], (DEPTH, KV_LORA)),
        "w_uq": nrm(ks[10], (DEPTH, Q_LORA, MLA_HEADS * (QK_NOPE + QK_ROPE)), Q_LORA),
        "w_ukv": nrm(ks[11], (DEPTH, KV_LORA, MLA_HEADS * (QK_NOPE + V_HEAD)), KV_LORA),
        "hgrn_lb": 0.1 * jax.random.normal(ks[12], (DEPTH + 1, 2, HG_HEADS, HG_FDIM), f32),
        "hgrn_o_norm": gain(ks[13], (DEPTH, HG_IDIM)),
        "w_br_mla": nrm(ks[14], (DEPTH, MLA_WIDTH, D_MODEL), MLA_WIDTH),
        "w_br_hgrn": nrm(ks[15], (DEPTH, HG_IW, D_MODEL), HG_IW),
        "w_out": nrm(ks[16], (DEPTH, D_MODEL, D_MODEL), D_MODEL),
        "w_ffn_in": nrm(ks[17], (DEPTH, D_MODEL, 2 * D_FF), D_MODEL),
        "w_ffn_out": nrm(ks[18], (DEPTH, D_FF, D_MODEL), D_FF),
    }


def reference(x, c, ctx, c_ctx, w_mod, b_mod, norm_g, w_in, mla_q_norm, mla_kv_norm, w_uq, w_ukv,
              hgrn_lb, hgrn_o_norm, w_br_mla, w_br_hgrn, w_out, w_ffn_in, w_ffn_out):
    bsz, length, _ = x.shape
    rows = length // GRID_W
    rope = axial_rope_tables(rows)
    lb_all = jnp.cumsum(jax.nn.softmax(hgrn_lb.astype(jnp.float32), axis=0), axis=0)
    zero_state = jnp.zeros((bsz, HG_HEADS, HG_FDIM, HG_IDIM), jnp.float32)
    for layer in range(DEPTH):
        last = layer == DEPTH - 1
        mod = jax.nn.silu(c) @ w_mod[layer] + b_mod[layer]
        mod_c = jax.nn.silu(c_ctx) @ w_mod[layer] + b_mod[layer]
        sh_a, sc_a, gt_a, sh_f, sc_f, gt_f = [t[:, None, :] for t in jnp.split(mod, N_MOD, axis=-1)]
        csh_a, csc_a, cgt_a, csh_f, csc_f, cgt_f = jnp.split(mod_c, N_MOD, axis=-1)

        h = modulate(rmsnorm(x, norm_g[layer, 0]), sh_a, sc_a)
        hc = modulate(rmsnorm(ctx, norm_g[layer, 0]), csh_a, csc_a)
        (q_l, k_l, v_l), hg_l, gl_l = mixer_projections(
            h, w_in[layer], mla_q_norm[layer], mla_kv_norm[layer], w_uq[layer], w_ukv[layer], lb_all[layer], rope)
        (q_c, k_c, v_c), hg_c, gl_c = mixer_projections(
            hc, w_in[layer], mla_q_norm[layer], mla_kv_norm[layer], w_uq[layer], w_ukv[layer], lb_all[layer], None)
        attn_l = block_attention(q_l, jnp.concatenate([k_c, k_l], axis=1), jnp.concatenate([v_c, v_l], axis=1))
        hgo_c, s_f, s_b = hgrn2_bidirectional(*hg_c[:6], zero_state, zero_state)
        hgo_l, _, _ = hgrn2_bidirectional(*hg_l[:6], s_f, s_b)
        out_l = merge_branches(attn_l, hgo_l, hg_l[6], gl_l, hgrn_o_norm[layer],
                               w_br_mla[layer], w_br_hgrn[layer], w_out[layer])
        x = x + gt_a * rmsnorm(out_l, norm_g[layer, 1])
        h = modulate(rmsnorm(x, norm_g[layer, 2]), sh_f, sc_f)
        x = x + gt_f * rmsnorm(swiglu(h, w_ffn_in[layer], w_ffn_out[layer]), norm_g[layer, 3])

        if not last:
            attn_c = block_attention(q_c, k_c, v_c)
            out_c = merge_branches(attn_c, hgo_c, hg_c[6], gl_c, hgrn_o_norm[layer],
                                   w_br_mla[layer], w_br_hgrn[layer], w_out[layer])
            ctx = ctx + cgt_a * rmsnorm(out_c, norm_g[layer, 1])
            hc = modulate(rmsnorm(ctx, norm_g[layer, 2]), csh_f, csc_f)
            ctx = ctx + cgt_f * rmsnorm(swiglu(hc, w_ffn_in[layer], w_ffn_out[layer]), norm_g[layer, 3])
    return x
```

```cpp
#include <hip/hip_runtime.h>
#include <hip/hip_cooperative_groups.h>
#include <cstdio>
#include <cstdint>
namespace cg = cooperative_groups;
namespace pg8 {
#define PG8_LAS __attribute__((address_space(3)))
typedef unsigned short bf16_t;
typedef short bf16x8 __attribute__((ext_vector_type(8)));
typedef float f32x4 __attribute__((ext_vector_type(4)));
typedef unsigned u32x4 __attribute__((ext_vector_type(4)));
constexpr int BM = 256, BK = 64, HALF = 128, HTB = HALF * BK * 2  , STAGE_BYTES = 8 * HTB, NXCD = 8, WGM = 8;

__host__ __device__ __forceinline__ int lds_byte(int r, int c) { const int st = (r >> 4) * 2 + (c >> 5), rr = r & 15, cc = c & 31, ob = rr * 64 + cc * 2; return st * 1024 + (ob ^ (((ob >> 9) & 1) << 5)); }
__host__ __device__ __forceinline__ void stage_rc(int b, int& R, int& C) { const int st = b / 1024, sb = b % 1024, swz = sb ^ (((sb >> 9) & 1) << 5); R = (st >> 1) * 16 + swz / 64; C = (st & 1) * 32 + (swz % 64) / 2; }
__host__ __device__ __forceinline__ int perm32(int rho) { const int n = rho >> 4, i = rho & 15; return 8 * (i >> 2) + 4 * n + (i & 3); }

struct Unit { int pm, pn; };
struct Gemm { const bf16_t* A; const bf16_t* Bt; int M, N, K; };

struct StaticOrder {
    int nM, nN, nwg, G, c;
    __host__ __device__ void init(int M, int N, int G_, int c_) { nM = M / BM; nN = N / BM; nwg = nM * nN; G = G_; c = c_; }
    __host__ __device__ bool next(int i, Unit& u) const {
        const long L = (long)i * G + c; if (L >= nwg) return false;
        int wgid = (int)L; { const int q = nwg / NXCD, r = nwg % NXCD, xcd = wgid % NXCD, off = wgid / NXCD; wgid = (xcd < r ? xcd * (q + 1) : r * (q + 1) + (xcd - r) * q) + off; }
        const int nig = WGM * nN, gid = wgid / nig, fm = gid * WGM, gsz = (nM - fm) < WGM ? (nM - fm) : WGM;
        u.pm = fm + ((wgid % nig) % gsz); u.pn = (wgid % nig) / gsz; return true;
    }
    __device__ __forceinline__ void a_ready(const Unit&) const {}
    __device__ __forceinline__ void done(const Unit&) const {}
};

typedef __bf16 bf16x2_t __attribute__((ext_vector_type(2)));
typedef float f32x2_t __attribute__((ext_vector_type(2)));
__device__ __forceinline__ unsigned cvt_pk_bf16_safe(float lo, float hi) { const f32x2_t f = {lo, hi}; const bf16x2_t r = __builtin_convertvector(f, bf16x2_t); return __builtin_bit_cast(unsigned, r); }
__device__ __forceinline__ unsigned cvt_pk_bf16(float lo, float hi) { unsigned r; asm volatile("v_cvt_pk_bf16_f32 %0, %1, %2" : "=v"(r) : "v"(lo), "v"(hi)); return r; }
__device__ __forceinline__ u32x4 pack8s(const f32x4 v0, const f32x4 v1) { u32x4 w; w.x = cvt_pk_bf16_safe(v0[0], v0[1]); w.y = cvt_pk_bf16_safe(v0[2], v0[3]); w.z = cvt_pk_bf16_safe(v1[0], v1[1]); w.w = cvt_pk_bf16_safe(v1[2], v1[3]); return w; }
__device__ __forceinline__ u32x4 pack8(const f32x4 v0, const f32x4 v1) { u32x4 w; w.x = cvt_pk_bf16(v0[0], v0[1]); w.y = cvt_pk_bf16(v0[2], v0[3]); w.z = cvt_pk_bf16(v1[0], v1[1]); w.w = cvt_pk_bf16(v1[2], v1[3]); return w; }
__device__ __forceinline__ float bf_lo(unsigned w) { return __uint_as_float(w << 16); }
__device__ __forceinline__ float bf_hi(unsigned w) { return __uint_as_float(w & 0xffff0000u); }
__device__ __forceinline__ float sigm(float x) { return __builtin_amdgcn_rcpf(1.0f + __expf(-x)); }

struct Order {
    int nM, nN, nwg, G, c, lat;
    __device__ void init(int M, int N, int G_, int c_, int lat_) { nM = M / BM; nN = N / BM; nwg = nM * nN; G = G_; c = c_; lat = lat_; }
    __device__ bool next(int i, Unit& u) const {
        const long L = (long)i * G + c; if (L >= nwg) return false;
        int wgid = (int)L; { const int q = nwg / NXCD, r = nwg % NXCD, xcd = wgid % NXCD, off = wgid / NXCD; wgid = (xcd < r ? xcd * (q + 1) : r * (q + 1) + (xcd - r) * q) + off; }
        const int nig = WGM * nN, gid = wgid / nig, fm = gid * WGM, gsz = (nM - fm) < WGM ? (nM - fm) : WGM;
        int pm = fm + ((wgid % nig) % gsz); u.pn = (wgid % nig) / gsz;
        if (lat) pm = pm + (pm >> 5) + 1;
        u.pm = pm; return true;
    }
    __device__ __forceinline__ void a_ready(const Unit&) const {}
    __device__ __forceinline__ void done(const Unit&) const {}
};

struct EpiIn {
    static constexpr bool PERM = true, AFTER_DRAIN = false;
    bf16_t *CQ, *CKV, *KRR, *HGq, *HGff, *HGfb, *HGi, *HGg, *GATE;
    unsigned long long *SQ, *SKV; const float *RC, *RS;
    __device__ __forceinline__ void operator()(const f32x4 (&acc)[2][2][4][2], const Unit& u, int wr, int wc, int fr, int fq) const {
        const int pn = u.pn, pm = u.pm, bt = pm / 33; const bool isctx = (pm - bt * 33) == 0;
        if (pn < 3) {
            unsigned long long* S = pn < 2 ? SQ : SKV;
#pragma unroll
            for (int ai = 0; ai < 2; ++ai)
#pragma unroll
                for (int m = 0; m < 4; ++m) { float sq = 0.f;
#pragma unroll
                    for (int bj = 0; bj < 2; ++bj)
#pragma unroll
                        for (int n = 0; n < 2; ++n) { const f32x4 v = acc[ai][bj][m][n]; sq += (v[0] * v[0] + v[1] * v[1]) + (v[2] * v[2] + v[3] * v[3]); }
                    sq += __shfl_xor(sq, 16); sq += __shfl_xor(sq, 32);
                    if (fq == 0) (void)__hip_atomic_fetch_add(S + pm * BM + wr * 64 + fr + ai * HALF + m * 16, (unsigned long long)(sq * 4294967296.f), __ATOMIC_RELAXED, __HIP_MEMORY_SCOPE_AGENT); }
        }
        if (pn == 3) {
            const int lc = wc * 32 + 8 * fq; if (lc >= 64) return;
            const int i0 = lc >> 1, tt = pm - 33 * bt - 1;
#pragma unroll
            for (int ai = 0; ai < 2; ++ai)
#pragma unroll
                for (int m = 0; m < 4; ++m) { const int rl = wr * 64 + fr + ai * HALF + m * 16; f32x4 v0 = acc[ai][0][m][0], v1 = acc[ai][0][m][1];
                    if (!isctx) { const int t = tt * BM + rl; const f32x4 cs = *(const f32x4*)(RC + t * 32 + i0), sn = *(const f32x4*)(RS + t * 32 + i0); f32x4 x, y;
                        x[0] = v0[0] * cs[0] - v0[1] * sn[0]; x[1] = v0[1] * cs[0] + v0[0] * sn[0]; x[2] = v0[2] * cs[1] - v0[3] * sn[1]; x[3] = v0[3] * cs[1] + v0[2] * sn[1];
                        y[0] = v1[0] * cs[2] - v1[1] * sn[2]; y[1] = v1[1] * cs[2] + v1[0] * sn[2]; y[2] = v1[2] * cs[3] - v1[3] * sn[3]; y[3] = v1[3] * cs[3] + v1[2] * sn[3];
                        v0 = x; v1 = y; }
                    *(u32x4*)(KRR + (size_t)(pm * BM + rl) * 64 + lc) = pack8(v0, v1); }
            return; }
        bf16_t* base; int ldc, colt, act = 0, rowt = pm * BM, maxcol = 256;
        if (pn < 2) { base = CQ; ldc = 512; colt = pn * 256; }
        else if (pn == 2) { base = CKV; ldc = 256; colt = 0; }
        else if (pn == 3) { base = KRR; ldc = 64; colt = 0; maxcol = 64; }
        else if (pn < 8) { base = HGq; ldc = 1024; colt = (pn - 4) * 256; act = 1; }
        else if (pn < 12) { base = HGff; ldc = 1024; colt = (pn - 8) * 256; }
        else if (pn < 16) { base = HGfb; ldc = 1024; colt = (pn - 12) * 256; }
        else if (pn < 20) { base = HGi; ldc = 1024; colt = (pn - 16) * 256; }
        else if (pn < 24) { if (isctx) return; base = HGg; ldc = 1024; colt = (pn - 20) * 256; act = 2; }
        else { if (isctx) return; base = GATE; ldc = 4096; colt = (pn - 24) * 256; act = 3; rowt = (pm - bt - 1) * BM; }
        const int row0 = rowt + wr * 64 + fr, lc0 = wc * 32 + 8 * fq;
#pragma unroll
        for (int ai = 0; ai < 2; ++ai)
#pragma unroll
            for (int m = 0; m < 4; ++m) { bf16_t* rowp = base + (size_t)(row0 + ai * HALF + m * 16) * ldc + colt + lc0;
#pragma unroll
                for (int bj = 0; bj < 2; ++bj) { if (lc0 + bj * HALF >= maxcol) continue;
                    f32x4 v0 = acc[ai][bj][m][0], v1 = acc[ai][bj][m][1];
                    if (act == 1) {
#pragma unroll
                        for (int e = 0; e < 4; ++e) { v0[e] = v0[e] * sigm(v0[e]) * 0.08838834764831845f; v1[e] = v1[e] * sigm(v1[e]) * 0.08838834764831845f; } }
                    else if (act == 2) {
#pragma unroll
                        for (int e = 0; e < 4; ++e) { v0[e] = v0[e] * sigm(v0[e]); v1[e] = v1[e] * sigm(v1[e]); } }
                    else if (act == 3) {
#pragma unroll
                        for (int e = 0; e < 4; ++e) { v0[e] = sigm(v0[e]); v1[e] = sigm(v1[e]); } }
                    *(u32x4*)(rowp + bj * HALF) = pack8(v0, v1); } }
    }
};
struct EpiQ {
    static constexpr bool PERM = true, AFTER_DRAIN = false;
    bf16_t* Q; const float* RC; const float* RS; const unsigned long long* SQ;
    __device__ __forceinline__ void operator()(const f32x4 (&acc)[2][2][4][2], const Unit& u, int wr, int wc, int fr, int fq) const {
        const int pm = u.pm, bt = pm / 33, mt = pm - bt - 1, tt = pm - 33 * bt - 1;
        const int row0 = wr * 64 + fr;
#pragma unroll
        for (int bj = 0; bj < 2; ++bj) {
            const int c0 = u.pn * BM + bj * HALF + wc * 32 + 8 * fq; const int cm = c0 % 192; const bool rope = cm >= 128; const int j0 = (cm - 128) >> 1;
#pragma unroll
            for (int ai = 0; ai < 2; ++ai)
#pragma unroll
                for (int m = 0; m < 4; ++m) { const int rl = row0 + ai * HALF + m * 16;
                    const float rs = rsqrtf((float)__hip_atomic_load(SQ + pm * BM + rl, __ATOMIC_RELAXED, __HIP_MEMORY_SCOPE_AGENT) * (2.3283064365386963e-10f / 512.f) + 1e-6f);
                    f32x4 v0 = acc[ai][bj][m][0] * rs, v1 = acc[ai][bj][m][1] * rs;
                    if (rope) { const int t = tt * BM + rl; const f32x4 cs = *(const f32x4*)(RC + t * 32 + j0), sn = *(const f32x4*)(RS + t * 32 + j0);
                        f32x4 a, b;
                        a[0] = v0[0] * cs[0] - v0[1] * sn[0]; a[1] = v0[1] * cs[0] + v0[0] * sn[0]; a[2] = v0[2] * cs[1] - v0[3] * sn[1]; a[3] = v0[3] * cs[1] + v0[2] * sn[1];
                        b[0] = v1[0] * cs[2] - v1[1] * sn[2]; b[1] = v1[1] * cs[2] + v1[0] * sn[2]; b[2] = v1[2] * cs[3] - v1[3] * sn[3]; b[3] = v1[3] * cs[3] + v1[2] * sn[3];
                        v0 = a; v1 = b; }
                    *(u32x4*)(Q + (size_t)(mt * BM + rl) * 1536 + c0) = pack8(v0, v1); } }
    }
};
struct EpiKV {
    static constexpr bool PERM = true, AFTER_DRAIN = false;
    bf16_t *KN, *VV; const unsigned long long* SKV;
    __device__ __forceinline__ void operator()(const f32x4 (&acc)[2][2][4][2], const Unit& u, int wr, int wc, int fr, int fq) const {
        const int row0 = u.pm * BM + wr * 64 + fr, col0 = u.pn * 128 + wc * 32 + 8 * fq;
#pragma unroll
        for (int ai = 0; ai < 2; ++ai)
#pragma unroll
            for (int m = 0; m < 4; ++m) { const int r = row0 + ai * HALF + m * 16; const size_t off = (size_t)r * 1024 + col0;
                const float rs = rsqrtf((float)__hip_atomic_load(SKV + r, __ATOMIC_RELAXED, __HIP_MEMORY_SCOPE_AGENT) * (2.3283064365386963e-10f / 256.f) + 1e-6f);
                *(u32x4*)(KN + off) = pack8(acc[ai][0][m][0] * rs, acc[ai][0][m][1] * rs);
                *(u32x4*)(VV + off) = pack8(acc[ai][1][m][0] * rs, acc[ai][1][m][1] * rs); }
    }
};
template <bool ADD> struct EpiGate {
    static constexpr bool PERM = true, AFTER_DRAIN = false;
    bf16_t* O; const bf16_t* G; const bf16_t* A; int goff, lat;
    __device__ __forceinline__ void operator()(const f32x4 (&acc)[2][2][4][2], const Unit& u, int wr, int wc, int fr, int fq) const {
        const int row0 = (lat ? u.pm - u.pm / 33 - 1 : u.pm) * BM + wr * 64 + fr, col0 = u.pn * BM + wc * 32 + 8 * fq;
#pragma unroll
        for (int ai = 0; ai < 2; ++ai)
#pragma unroll
            for (int m = 0; m < 4; ++m) { const size_t r = (size_t)(row0 + ai * HALF + m * 16);
#pragma unroll
                for (int bj = 0; bj < 2; ++bj) { const int c = col0 + bj * HALF; const u32x4 g = *(const u32x4*)(G + r * 4096 + goff + c);
                    f32x4 v0 = acc[ai][bj][m][0], v1 = acc[ai][bj][m][1];
                    v0[0] *= bf_lo(g.x); v0[1] *= bf_hi(g.x); v0[2] *= bf_lo(g.y); v0[3] *= bf_hi(g.y); v1[0] *= bf_lo(g.z); v1[1] *= bf_hi(g.z); v1[2] *= bf_lo(g.w); v1[3] *= bf_hi(g.w);
                    if (ADD) { const u32x4 a = *(const u32x4*)(A + r * 2048 + c);
                        v0[0] += bf_lo(a.x); v0[1] += bf_hi(a.x); v0[2] += bf_lo(a.y); v0[3] += bf_hi(a.y); v1[0] += bf_lo(a.z); v1[1] += bf_hi(a.z); v1[2] += bf_lo(a.w); v1[3] += bf_hi(a.w); }
                    *(u32x4*)(O + r * 2048 + c) = pack8(v0, v1); } }
    }
};
struct EpiPlain {
    static constexpr bool PERM = true, AFTER_DRAIN = false;
    bf16_t* O; int ldc;
    __device__ __forceinline__ void operator()(const f32x4 (&acc)[2][2][4][2], const Unit& u, int wr, int wc, int fr, int fq) const {
        const int row0 = u.pm * BM + wr * 64 + fr, col0 = u.pn * BM + wc * 32 + 8 * fq;
#pragma unroll
        for (int ai = 0; ai < 2; ++ai)
#pragma unroll
            for (int m = 0; m < 4; ++m) { bf16_t* rowp = O + (size_t)(row0 + ai * HALF + m * 16) * ldc + col0;
#pragma unroll
                for (int bj = 0; bj < 2; ++bj) *(u32x4*)(rowp + bj * HALF) = pack8(acc[ai][bj][m][0], acc[ai][bj][m][1]); }
    }
};
struct OrderPanel {
    int G, c;
    __device__ void init(int G_, int c_) { G = G_; c = c_; }
    __device__ bool next(int i, Unit& u) const {
        const int ppx = G >> 6;
        if (ppx == 0 || (G & 63)) return false;
        const int x = c & 7, j = c >> 3, panel = (i * 8 + x) * ppx + (j >> 3);
        if (panel >= 128) return false;
        u.pm = panel; u.pn = j & 7; return true;
    }
    __device__ __forceinline__ void a_ready(const Unit&) const {}
    __device__ __forceinline__ void done(const Unit&) const {}
};
__device__ __forceinline__ void panel_publish(unsigned long long* S, unsigned* cnt, const float (&ss)[2][4], int row0, int fr, int fq) {
    if (fq == 0) {
#pragma unroll
        for (int ai = 0; ai < 2; ++ai)
#pragma unroll
            for (int m = 0; m < 4; ++m) (void)__hip_atomic_fetch_add(S + row0 + ai * HALF + m * 16, (unsigned long long)(ss[ai][m] * 4294967296.f), __ATOMIC_RELAXED, __HIP_MEMORY_SCOPE_AGENT);
    }
    asm volatile("s_waitcnt vmcnt(0)" ::: "memory");
    if (fr == 0 && fq == 0) { (void)__hip_atomic_fetch_add(cnt, 1u, __ATOMIC_RELAXED, __HIP_MEMORY_SCOPE_AGENT);
        unsigned sp = 0; while (__hip_atomic_load(cnt, __ATOMIC_RELAXED, __HIP_MEMORY_SCOPE_AGENT) < 64u) { __builtin_amdgcn_s_sleep(1); if (++sp > (1u << 22)) break; } }
    asm volatile("" ::: "memory");
}
__device__ __forceinline__ float panel_rstd(const unsigned long long* S, int row) {
    const unsigned long long v = __hip_atomic_load(S + row, __ATOMIC_RELAXED, __HIP_MEMORY_SCOPE_AGENT);
    return rsqrtf((float)v * (2.3283064365386963e-10f / 2048.f) + 1e-6f);
}
struct EpiRes1 {
    static constexpr bool PERM = true, AFTER_DRAIN = false;
    const float* X; float* X1; bf16_t* H2; const float* MOD; const float* NG; unsigned long long *S1, *S2; unsigned *C1, *C2;
    __device__ __forceinline__ void operator()(f32x4 (&acc)[2][2][4][2], const Unit& u, int wr, int wc, int fr, int fq) const {
        const int row0 = u.pm * BM + wr * 64 + fr, col0 = u.pn * BM + wc * 32 + 8 * fq; const float* mod = MOD + (u.pm >> 5) * 12288;
        float ss[2][4];
#pragma unroll
        for (int ai = 0; ai < 2; ++ai)
#pragma unroll
            for (int m = 0; m < 4; ++m) { float s = 0.f;
#pragma unroll
                for (int bj = 0; bj < 2; ++bj)
#pragma unroll
                    for (int n = 0; n < 2; ++n) { const f32x4 v = acc[ai][bj][m][n]; s += (v[0] * v[0] + v[1] * v[1]) + (v[2] * v[2] + v[3] * v[3]); }
                s += __shfl_xor(s, 16); s += __shfl_xor(s, 32); ss[ai][m] = s; }
        panel_publish(S1, C1 + 64 * u.pm, ss, row0, fr, fq);
        f32x4 g1[2][2], gt[2][2];
#pragma unroll
        for (int bj = 0; bj < 2; ++bj)
#pragma unroll
            for (int n = 0; n < 2; ++n) { const int c = col0 + bj * HALF + 4 * n; g1[bj][n] = *(const f32x4*)(NG + 2048 + c); gt[bj][n] = *(const f32x4*)(mod + 2 * 2048 + c); }
#pragma unroll
        for (int ai = 0; ai < 2; ++ai)
#pragma unroll
            for (int m = 0; m < 4; ++m) { const int r = row0 + ai * HALF + m * 16; const float rs = panel_rstd(S1, r); float s = 0.f;
#pragma unroll
                for (int bj = 0; bj < 2; ++bj)
#pragma unroll
                    for (int n = 0; n < 2; ++n) { const size_t off = (size_t)r * 2048 + col0 + bj * HALF + 4 * n; const f32x4 xv = *(const f32x4*)(X + off);
                        const f32x4 v = xv + gt[bj][n] * (acc[ai][bj][m][n] * rs * g1[bj][n]); acc[ai][bj][m][n] = v; *(f32x4*)(X1 + off) = v;
                        s += (v[0] * v[0] + v[1] * v[1]) + (v[2] * v[2] + v[3] * v[3]); }
                s += __shfl_xor(s, 16); s += __shfl_xor(s, 32); ss[ai][m] = s; }
        panel_publish(S2, C2 + 64 * u.pm, ss, row0, fr, fq);
#pragma unroll
        for (int bj = 0; bj < 2; ++bj) { f32x4 g2[2], sh[2], sc[2];
#pragma unroll
            for (int n = 0; n < 2; ++n) { const int c = col0 + bj * HALF + 4 * n; g2[n] = *(const f32x4*)(NG + 2 * 2048 + c); sh[n] = *(const f32x4*)(mod + 3 * 2048 + c); sc[n] = *(const f32x4*)(mod + 4 * 2048 + c) + 1.0f; }
#pragma unroll
            for (int ai = 0; ai < 2; ++ai)
#pragma unroll
                for (int m = 0; m < 4; ++m) { const int r = row0 + ai * HALF + m * 16; const float rs = panel_rstd(S2, r);
                    const f32x4 h0 = (acc[ai][bj][m][0] * rs * g2[0]) * sc[0] + sh[0], h1 = (acc[ai][bj][m][1] * rs * g2[1]) * sc[1] + sh[1];
                    *(u32x4*)(H2 + (size_t)r * 2048 + col0 + bj * HALF) = pack8(h0, h1); } }
    }
};
struct EpiRes2 {
    static constexpr bool PERM = true, AFTER_DRAIN = false;
    float* OUT; const float* MOD; const float* NG; unsigned long long* S3; unsigned* C3;
    __device__ __forceinline__ void operator()(f32x4 (&acc)[2][2][4][2], const Unit& u, int wr, int wc, int fr, int fq) const {
        const int row0 = u.pm * BM + wr * 64 + fr, col0 = u.pn * BM + wc * 32 + 8 * fq; const float* mod = MOD + (u.pm >> 5) * 12288;
        float ss[2][4];
#pragma unroll
        for (int ai = 0; ai < 2; ++ai)
#pragma unroll
            for (int m = 0; m < 4; ++m) { float s = 0.f;
#pragma unroll
                for (int bj = 0; bj < 2; ++bj)
#pragma unroll
                    for (int n = 0; n < 2; ++n) { const f32x4 v = acc[ai][bj][m][n]; s += (v[0] * v[0] + v[1] * v[1]) + (v[2] * v[2] + v[3] * v[3]); }
                s += __shfl_xor(s, 16); s += __shfl_xor(s, 32); ss[ai][m] = s; }
        panel_publish(S3, C3 + 64 * u.pm, ss, row0, fr, fq);
        f32x4 g3[2][2], gt[2][2];
#pragma unroll
        for (int bj = 0; bj < 2; ++bj)
#pragma unroll
            for (int n = 0; n < 2; ++n) { const int c = col0 + bj * HALF + 4 * n; g3[bj][n] = *(const f32x4*)(NG + 3 * 2048 + c); gt[bj][n] = *(const f32x4*)(mod + 5 * 2048 + c); }
#pragma unroll
        for (int ai = 0; ai < 2; ++ai)
#pragma unroll
            for (int m = 0; m < 4; ++m) { const int r = row0 + ai * HALF + m * 16; const float rs = panel_rstd(S3, r);
#pragma unroll
                for (int bj = 0; bj < 2; ++bj)
#pragma unroll
                    for (int n = 0; n < 2; ++n) { const size_t off = (size_t)r * 2048 + col0 + bj * HALF + 4 * n; const f32x4 xv = *(const f32x4*)(OUT + off);
                        *(f32x4*)(OUT + off) = xv + gt[bj][n] * (acc[ai][bj][m][n] * rs * g3[bj][n]); } }
    }
};
struct EpiSwiGLU {
    static constexpr bool PERM = true, AFTER_DRAIN = false;
    bf16_t* O;
    __device__ __forceinline__ void operator()(const f32x4 (&acc)[2][2][4][2], const Unit& u, int wr, int wc, int fr, int fq) const {
        typedef unsigned u32x2v __attribute__((ext_vector_type(2)));
        const int row0 = u.pm * BM + wr * 64 + fr, col0 = u.pn * 128 + wc * 16 + 4 * fq;
#pragma unroll
        for (int ai = 0; ai < 2; ++ai)
#pragma unroll
            for (int m = 0; m < 4; ++m) { bf16_t* rowp = O + (size_t)(row0 + ai * HALF + m * 16) * 5632 + col0;
#pragma unroll
                for (int bj = 0; bj < 2; ++bj) { const f32x4 a = acc[ai][bj][m][0], b = acc[ai][bj][m][1]; f32x4 r;
#pragma unroll
                    for (int e = 0; e < 4; ++e) r[e] = a[e] * sigm(a[e]) * b[e];
                    u32x2v w; w.x = cvt_pk_bf16(r[0], r[1]); w.y = cvt_pk_bf16(r[2], r[3]); *(u32x2v*)(rowp + bj * 64) = w; } }
    }
};

template <class Epi, class Sched, bool ALIGN_EPI = false, bool SP2 = false>
__device__ __forceinline__ void gemm_phase(PG8_LAS unsigned char* lds, const Gemm g, const Sched& S, const Epi& E, const int wid) {
    int lane; asm volatile("v_mbcnt_lo_u32_b32 %0, -1, 0\n\tv_mbcnt_hi_u32_b32 %0, -1, %0" : "=v"(lane)); const int tid = wid * 64 + lane, wr = wid >> 2, wc = wid & 3, fr = lane & 15, fq = lane >> 4;
    const int K = g.K, nt = K / BK;
    unsigned voffA[2], voffB[2];
#pragma unroll
    for (int i = 0; i < 2; ++i) { int R, C; stage_rc(tid * 16 + i * 8192, R, C); const int Rb = Epi::PERM ? ((R & ~31) + perm32(R & 31)) : R;
        voffA[i] = (unsigned)(R * K + C) * 2u; voffB[i] = (unsigned)(Rb * K + C) * 2u; }
    const size_t kstep = (size_t)(BK * 2);
    const size_t hstep = (size_t)HALF * K * 2;
    const size_t tstep = 2 * hstep;
    const unsigned ldsw = (unsigned)wid * 1024u;
    const int aoff = lds_byte(wr * 64 + fr, fq * 8), boff = lds_byte(wc * 32 + fr, fq * 8);
#define PG8_SA(b, h) (((b) * 2 + (h)) * HTB)
#define PG8_SB(b, h) ((4 + (b) * 2 + (h)) * HTB)
#define PG8_STAGE(bufoff, gbase, voff) do { _Pragma("unroll") for (int _i = 0; _i < 2; ++_i) \
        __builtin_amdgcn_global_load_lds((const unsigned*)((const char*)(gbase) + (voff)[_i]), (PG8_LAS unsigned*)(lds + (bufoff) + ldsw + _i * 8192), 16, 0, 0); } while (0)
#define PG8_LDA(dst, b, h) do { _Pragma("unroll") for (int m = 0; m < 4; ++m) _Pragma("unroll") for (int k = 0; k < 2; ++k) dst[m][k] = *(const PG8_LAS bf16x8*)(lds + PG8_SA(b, h) + aoff + m * 2048 + k * 1024); } while (0)
#define PG8_LDB(dst, b, h) do { _Pragma("unroll") for (int n = 0; n < 2; ++n) _Pragma("unroll") for (int k = 0; k < 2; ++k) dst[n][k] = *(const PG8_LAS bf16x8*)(lds + PG8_SB(b, h) + boff + n * 2048 + k * 1024); } while (0)
#define PG8_MMA(ai, bj, At, Bt) do { __builtin_amdgcn_s_setprio(1); _Pragma("unroll") for (int m = 0; m < 4; ++m) _Pragma("unroll") for (int n = 0; n < 2; ++n) _Pragma("unroll") for (int k = 0; k < 2; ++k) \
        acc[ai][bj][m][n] = __builtin_amdgcn_mfma_f32_16x16x32_bf16(Bt[n][k], At[m][k], acc[ai][bj][m][n], 0, 0, 0); __builtin_amdgcn_s_setprio(0); } while (0)
#define PG8_WAIT_V(n) asm volatile("s_waitcnt vmcnt(" #n ")" ::: "memory")
#define PG8_WAIT_L(n) asm volatile("s_waitcnt lgkmcnt(" #n ")" ::: "memory")
#define PG8_BAR __builtin_amdgcn_s_barrier()
#define PG8_SCHED __builtin_amdgcn_sched_barrier(0)
    Unit cur, nxt; int ui = 0;
    if (!S.next(0, cur)) return;
    f32x4 acc[2][2][4][2];
#pragma unroll
    for (int a = 0; a < 2; ++a)
#pragma unroll
        for (int b = 0; b < 2; ++b)
#pragma unroll
            for (int m = 0; m < 4; ++m)
#pragma unroll
                for (int n = 0; n < 2; ++n) acc[a][b][m][n] = (f32x4){0.f, 0.f, 0.f, 0.f};
    bf16x8 At[4][2], B0[2][2], B1[2][2];
    const char* cA = (const char*)g.A + (size_t)cur.pm * tstep; const char* cB = (const char*)g.Bt + (size_t)cur.pn * tstep;
    S.a_ready(cur);
    if constexpr (SP2) {
        PG8_STAGE(PG8_SB(0, 0), cB, voffB); PG8_STAGE(PG8_SB(0, 1), cB + hstep, voffB); PG8_STAGE(PG8_SA(0, 0), cA, voffA); PG8_STAGE(PG8_SA(0, 1), cA + hstep, voffA);
        if (wr == 1) PG8_BAR;
        PG8_WAIT_V(2); PG8_BAR;
        PG8_STAGE(PG8_SB(1, 0), cB + kstep, voffB); PG8_STAGE(PG8_SA(1, 0), cA + kstep, voffA); PG8_STAGE(PG8_SB(1, 1), cB + hstep + kstep, voffB);
        PG8_WAIT_V(6); PG8_BAR;
    } else {
        PG8_STAGE(PG8_SB(0, 0), cB, voffB); PG8_STAGE(PG8_SA(0, 0), cA, voffA); PG8_STAGE(PG8_SB(0, 1), cB + hstep, voffB); PG8_STAGE(PG8_SA(0, 1), cA + hstep, voffA);
        if (wr == 1) PG8_BAR;
        PG8_WAIT_V(4); PG8_BAR;
        PG8_STAGE(PG8_SB(1, 0), cB + kstep, voffB); PG8_STAGE(PG8_SA(1, 0), cA + kstep, voffA); PG8_STAGE(PG8_SB(1, 1), cB + hstep + kstep, voffB);
        PG8_WAIT_V(6); PG8_BAR;
    }
    for (;;) {
        const bool has_next = S.next(ui + 1, nxt);
        const char* nA = has_next ? (const char*)g.A + (size_t)nxt.pm * tstep : cA; const char* nB = has_next ? (const char*)g.Bt + (size_t)nxt.pn * tstep : cB;
        for (int t = 0; t < nt; t += 2) {
            const bool last = (t == nt - 2);
            const char* a1 = cA + (size_t)(t + 1) * kstep;
            const char* a2 = last ? nA : cA + (size_t)(t + 2) * kstep; const char* b2 = last ? nB : cB + (size_t)(t + 2) * kstep;
            const char* a3 = a2 + kstep; const char* b3 = b2 + kstep;
            if (last && has_next) S.a_ready(nxt);
            if constexpr (SP2) {
            PG8_LDB(B0, 0, 0); PG8_LDB(B1, 0, 1); PG8_SCHED; PG8_LDA(At, 0, 0); PG8_STAGE(PG8_SA(1, 1), a1 + hstep, voffA);
            PG8_WAIT_V(8); PG8_WAIT_L(0); PG8_BAR; PG8_MMA(0, 0, At, B0); PG8_MMA(0, 1, At, B1); PG8_BAR; PG8_SCHED;
            PG8_LDA(At, 0, 1); PG8_STAGE(PG8_SB(0, 0), b2, voffB); PG8_STAGE(PG8_SB(0, 1), b2 + hstep, voffB); PG8_STAGE(PG8_SA(0, 0), a2, voffA);
            PG8_WAIT_V(8); PG8_WAIT_L(0); PG8_BAR; PG8_MMA(1, 0, At, B0); PG8_MMA(1, 1, At, B1); PG8_BAR; PG8_SCHED;
            PG8_LDB(B0, 1, 0); PG8_LDB(B1, 1, 1); PG8_SCHED; PG8_LDA(At, 1, 0); PG8_STAGE(PG8_SA(0, 1), a2 + hstep, voffA);
            PG8_WAIT_V(8); PG8_WAIT_L(0); PG8_BAR; PG8_MMA(0, 0, At, B0); PG8_MMA(0, 1, At, B1); PG8_BAR; PG8_SCHED;
            PG8_LDA(At, 1, 1); PG8_STAGE(PG8_SB(1, 0), b3, voffB); PG8_STAGE(PG8_SB(1, 1), b3 + hstep, voffB); PG8_STAGE(PG8_SA(1, 0), a3, voffA);
            PG8_WAIT_V(8); PG8_WAIT_L(0); PG8_BAR; PG8_MMA(1, 0, At, B0); PG8_MMA(1, 1, At, B1); PG8_BAR; PG8_SCHED;
            } else {
            PG8_LDB(B0, 0, 0); PG8_SCHED; PG8_LDA(At, 0, 0); PG8_STAGE(PG8_SA(1, 1), a1 + hstep, voffA);
            PG8_WAIT_L(8); PG8_BAR; PG8_WAIT_L(0); PG8_MMA(0, 0, At, B0); PG8_BAR; PG8_SCHED;
            PG8_LDB(B1, 0, 1); PG8_STAGE(PG8_SB(0, 0), b2, voffB);
            PG8_BAR; PG8_WAIT_L(0); PG8_MMA(0, 1, At, B1); PG8_BAR;
            PG8_LDA(At, 0, 1); PG8_STAGE(PG8_SA(0, 0), a2, voffA);
            PG8_BAR; PG8_WAIT_L(0); PG8_MMA(1, 0, At, B0); PG8_BAR; PG8_SCHED;
            PG8_STAGE(PG8_SB(0, 1), b2 + hstep, voffB);
            PG8_WAIT_V(6); PG8_BAR; PG8_MMA(1, 1, At, B1); PG8_BAR;
            PG8_LDB(B0, 1, 0); PG8_SCHED; PG8_LDA(At, 1, 0); PG8_STAGE(PG8_SA(0, 1), a2 + hstep, voffA);
            PG8_WAIT_L(8); PG8_BAR; PG8_WAIT_L(0); PG8_MMA(0, 0, At, B0); PG8_BAR; PG8_SCHED;
            PG8_LDB(B1, 1, 1); PG8_STAGE(PG8_SB(1, 0), b3, voffB);
            PG8_BAR; PG8_WAIT_L(0); PG8_MMA(0, 1, At, B1); PG8_BAR;
            PG8_LDA(At, 1, 1); PG8_STAGE(PG8_SA(1, 0), a3, voffA);
            PG8_BAR; PG8_WAIT_L(0); PG8_MMA(1, 0, At, B0); PG8_BAR; PG8_SCHED;
            PG8_STAGE(PG8_SB(1, 1), b3 + hstep, voffB);
            PG8_WAIT_V(6); PG8_BAR; PG8_MMA(1, 1, At, B1); PG8_BAR;
            }
        }
        if constexpr (ALIGN_EPI) { if (wr == 0) PG8_BAR; }
        if constexpr (!Epi::AFTER_DRAIN) { asm volatile("s_nop 15\n\ts_nop 15" ::: "memory");   E(acc, cur, wr, wc, fr, fq); S.done(cur); }
        if (!has_next) break;
#pragma unroll
        for (int a = 0; a < 2; ++a)
#pragma unroll
            for (int b = 0; b < 2; ++b)
#pragma unroll
                for (int m = 0; m < 4; ++m)
#pragma unroll
                    for (int n = 0; n < 2; ++n) acc[a][b][m][n] = (f32x4){0.f, 0.f, 0.f, 0.f};
        cur = nxt; cA = nA; cB = nB; ++ui;
        if constexpr (ALIGN_EPI) { if (wr == 1) PG8_BAR; }
    }
    PG8_WAIT_V(0);
    if constexpr (!ALIGN_EPI) { if (wr == 0) PG8_BAR; }
    PG8_BAR;
    if constexpr (Epi::AFTER_DRAIN) { E.fused(acc, cur, wr, wc, fr, fq, lds, wid, lane); S.done(cur); }
#undef PG8_SA
#undef PG8_SB
#undef PG8_STAGE
#undef PG8_LDA
#undef PG8_LDB
#undef PG8_MMA
#undef PG8_WAIT_V
#undef PG8_WAIT_L
#undef PG8_BAR
#undef PG8_SCHED
}
}

#define PG8_SP2 true
#define PG8_ALIGN true
#define LAS __attribute__((address_space(3)))
typedef unsigned short bf16;
typedef short bf16x8 __attribute__((ext_vector_type(8)));
typedef short s16x4 __attribute__((ext_vector_type(4)));
typedef float f32x4 __attribute__((ext_vector_type(4)));
typedef float f32x16 __attribute__((ext_vector_type(16)));
typedef unsigned u32x4 __attribute__((ext_vector_type(4)));
typedef unsigned u32x2 __attribute__((ext_vector_type(2)));
using pg8::cvt_pk_bf16; using pg8::bf_lo; using pg8::bf_hi; using pg8::sigm;

constexpr int DM = 2048, NB = 4, SEQ = 8192, CTXL = 256, RB = SEQ + CTXL, MR = NB * RB, ML = NB * SEQ;
constexpr int NINP = 10240, DFF = 5632, NW = 8, NTHR = 512;
constexpr float RMS_EPS = 1e-6f;
constexpr float QSCALE = 0.07216878364870322f * 1.4426950408889634f;
constexpr size_t MiB = 1u << 20;
constexpr size_t WS_CTL = 0, WS_MOD = 1664 * 1024, WS_ROPEC = 2 * MiB, WS_ROPES = WS_ROPEC + MiB;
constexpr size_t WS_STAT = 64 * 1024, STAT_BYTES = 1536 * 1024, STAT_SQ = 917504;
static_assert(WS_STAT + STAT_BYTES <= WS_MOD && WS_MOD + 5 * 12288 * 4 <= WS_ROPEC, "control / statistics / modulation / rope map");
constexpr size_t WS_WUQ = 4 * MiB, WS_WUKV = 6 * MiB, WS_WBRA = 8 * MiB, WS_WBRH = 12 * MiB, WS_WOUT = 16 * MiB;
constexpr size_t WS_WIN = 24 * MiB, WS_CQ = 64 * MiB, WS_CKV = 97 * MiB, WS_KRR = WS_CKV + (size_t)MR * 256 * 2  , WS_ATTO = 24 * MiB;
constexpr size_t WS_KR = 118 * MiB;
constexpr size_t WS_H = 124 * MiB, WS_KN = 124 * MiB, WS_VV = 190 * MiB, WS_HGO = 124 * MiB, WS_ACT = 124 * MiB;
constexpr size_t WS_HGFF = 256 * MiB, WS_HGFB = 322 * MiB, WS_HGG = 388 * MiB, WS_HGQ = 454 * MiB, WS_HGI = 520 * MiB, WS_M1 = 124 * MiB, WS_T = 454 * MiB;
constexpr size_t WS_GATE = 586 * MiB, WS_OUTL = 586 * MiB, WS_H2 = 714 * MiB, WS_Y = 586 * MiB;
constexpr size_t WS_Q = 842 * MiB, WS_WFIN = 938 * MiB, WS_WFOUT = 982 * MiB, WS_END = 1004 * MiB;
static_assert(WS_KRR + (size_t)MR * 64 * 2 <= WS_KR && WS_KR + (size_t)MR * 64 * 2 <= WS_H && WS_CQ + (size_t)MR * 512 * 2 <= WS_CKV, "ws map 1");
static_assert(WS_H + (size_t)MR * DM * 2 <= WS_HGFF && WS_HGI + (size_t)MR * 1024 * 2 <= WS_GATE && WS_GATE + (size_t)ML * 4096 * 2 <= WS_Q && WS_Q + (size_t)ML * 1536 * 2 <= WS_WFIN, "ws map 2");
static_assert(WS_ACT + (size_t)ML * DFF * 2 <= WS_GATE && WS_WFIN + (size_t)2 * DFF * DM * 2 <= WS_WFOUT && WS_WFOUT + (size_t)DM * DFF * 2 <= WS_END, "ws map 3");
static_assert(WS_WIN + (size_t)NINP * DM * 2 <= WS_CQ && WS_ATTO + (size_t)ML * 1024 * 2 <= WS_CKV, "ws map 4");
constexpr int LDS_BYTES = 147456, LDS_MISC = 135168;

struct Args {
    const float *x, *c, *ctx, *c_ctx, *w_mod, *b_mod, *norm_g, *w_in, *q_norm, *kv_norm, *w_uq, *w_ukv, *hgrn_lb, *o_norm, *w_br_mla, *w_br_hgrn, *w_out, *w_ffn_in, *w_ffn_out;
    float* out; unsigned char* ws; int ph_lo, ph_hi;
};

__device__ __forceinline__ float wave_sum(float v) {
#pragma unroll
    for (int o = 1; o < 64; o <<= 1) v += __shfl_xor(v, o);
    return v;
}
#define LDS_WAIT() asm volatile("s_waitcnt lgkmcnt(0)" ::: "memory")
__device__ __forceinline__ int lane_now() { int l; asm volatile("v_mbcnt_lo_u32_b32 %0, -1, 0\n\tv_mbcnt_hi_u32_b32 %0, -1, %0" : "=v"(l)); return l; }

__device__ __forceinline__ int src_col(int mode, int n) {
    if (mode == 1) { if (n < 768) return n; if (n < 832) { const int j = n - 768; return 768 + (j >> 1) + 32 * (j & 1); } return n < 1024 ? -1 : n - 192; }
    if (mode == 2) { const int h = n / 192, c = n - h * 192; if (c < 128) return n; const int j = c - 128; return h * 192 + 128 + (j >> 1) + 32 * (j & 1); }
    if (mode == 3) { const int g = n >> 3, e = n & 7; return e < 4 ? 4 * g + e : DFF + 4 * g + (e - 4); }
    return n;
}
__device__ __forceinline__ void transpose_item(const float* W, int K, int Nsrc, int Ndst, bf16* WT, LAS float* scr, int item, int lane, int mode, float scale, const float* kscale = nullptr) {
    const int nblk = Ndst / 32, kb = item / nblk, nb = item - kb * nblk, k0 = 64 * kb, n0 = 32 * nb;
    const int sc = src_col(mode, n0 + (lane & 31));
#pragma unroll 8
    for (int i = 0; i < 32; ++i) { const int kk = 2 * i + (lane >> 5); scr[kk * 33 + (lane & 31)] = sc >= 0 ? W[(size_t)(k0 + kk) * Nsrc + sc] * (kscale ? scale * kscale[k0 + kk] : scale) : 0.f; }
    LDS_WAIT(); asm volatile("" ::: "memory");
    const int c = lane & 7;
#pragma unroll
    for (int j = 0; j < 4; ++j) { const int n = (lane >> 3) + 8 * j; const LAS float* s = scr + (8 * c) * 33 + n;
        u32x4 o; o.x = cvt_pk_bf16(s[0 * 33], s[1 * 33]); o.y = cvt_pk_bf16(s[2 * 33], s[3 * 33]); o.z = cvt_pk_bf16(s[4 * 33], s[5 * 33]); o.w = cvt_pk_bf16(s[6 * 33], s[7 * 33]);
        *(u32x4*)(WT + (size_t)(n0 + n) * K + k0 + 8 * c) = o; }
    LDS_WAIT(); asm volatile("" ::: "memory");
}
__device__ __forceinline__ void mod_gemv_item(const Args& a, LAS unsigned char* lds, int strip, int tid) {
    LAS float* S5 = (LAS float*)lds;
    LAS float* PART = (LAS float*)(lds + 40960);
    const int wave = tid >> 6, lane = tid & 63;
    for (int i = tid; i < 5 * DM; i += NTHR) { const int v = i / DM, k = i - v * DM; const float xv = v < 4 ? a.c[v * DM + k] : a.c_ctx[k]; S5[i] = xv * sigm(xv); }
    __syncthreads();
    const int kq = lane >> 4, c4 = lane & 15, cbase = strip * 64; const float* W = a.w_mod + cbase + 4 * c4;
    f32x4 acc[5];
#pragma unroll
    for (int v = 0; v < 5; ++v) acc[v] = (f32x4){0.f, 0.f, 0.f, 0.f};
    const int kb = wave * 256;
#pragma unroll 8
    for (int k = 0; k < 256; k += 4) { const int kk = kb + k + kq; const f32x4 w = *(const f32x4*)(W + (size_t)kk * (6 * DM));
#pragma unroll
        for (int v = 0; v < 5; ++v) acc[v] += w * S5[v * DM + kk]; }
#pragma unroll
    for (int v = 0; v < 5; ++v)
#pragma unroll
        for (int e = 0; e < 4; ++e) { float x = acc[v][e]; x += __shfl_xor(x, 16); x += __shfl_xor(x, 32); if (kq == 0) PART[(wave * 5 + v) * 64 + 4 * c4 + e] = x; }
    __syncthreads();
    if (tid < 320) { const int v = tid >> 6; float s = 0.f;
#pragma unroll
        for (int w = 0; w < 8; ++w) s += PART[(w * 5 + v) * 64 + lane];
        const int c0 = strip * 64 + lane; float* MOD = (float*)(a.ws + WS_MOD); MOD[v * (6 * DM) + c0] = s + a.b_mod[c0]; }
    __syncthreads();
}

__device__ __forceinline__ void p1_row(const Args& a, int R, int lane) {
    const int b = R / RB, r = R - b * RB; const float* src = r < CTXL ? a.ctx + ((size_t)b * CTXL + r) * DM : a.x + ((size_t)b * SEQ + (r - CTXL)) * DM;
    const float* MOD = (const float*)(a.ws + WS_MOD) + (r < CTXL ? 4 : b) * (6 * DM);
    f32x4 v[8]; float ss = 0.f;
#pragma unroll
    for (int j = 0; j < 8; ++j) { v[j] = *(const f32x4*)(src + 4 * (lane + 64 * j)); ss += (v[j][0] * v[j][0] + v[j][1] * v[j][1]) + (v[j][2] * v[j][2] + v[j][3] * v[j][3]); }
    const float rstd = rsqrtf(wave_sum(ss) * (1.f / DM) + RMS_EPS);
    bf16* H = (bf16*)(a.ws + WS_H) + (size_t)R * DM;
#pragma unroll
    for (int j = 0; j < 8; ++j) { const int c = 4 * (lane + 64 * j); const f32x4 g = *(const f32x4*)(a.norm_g + c), sh = *(const f32x4*)(MOD + c), sc = *(const f32x4*)(MOD + DM + c);
        f32x4 h;
#pragma unroll
        for (int e = 0; e < 4; ++e) h[e] = (v[j][e] * rstd * g[e]) * (1.f + sc[e]) + sh[e];
        u32x2 w; w.x = cvt_pk_bf16(h[0], h[1]); w.y = cvt_pk_bf16(h[2], h[3]); *(u32x2*)(H + c) = w; }
}
__device__ __forceinline__ void p3_row(const Args& a, int R, int lane) {
    const int b = R / RB, r = R - b * RB;
    { bf16* p = (bf16*)(a.ws + WS_CQ) + (size_t)R * 512 + 8 * lane; const u32x4 w = *(const u32x4*)p;
      float f[8] = {bf_lo(w.x), bf_hi(w.x), bf_lo(w.y), bf_hi(w.y), bf_lo(w.z), bf_hi(w.z), bf_lo(w.w), bf_hi(w.w)}; float ss = 0.f;
#pragma unroll
      for (int e = 0; e < 8; ++e) ss += f[e] * f[e];
      const float rstd = rsqrtf(wave_sum(ss) * (1.f / 512.f) + RMS_EPS); const float* g = a.q_norm + 8 * lane;
      u32x4 o; o.x = cvt_pk_bf16(f[0] * rstd * g[0], f[1] * rstd * g[1]); o.y = cvt_pk_bf16(f[2] * rstd * g[2], f[3] * rstd * g[3]); o.z = cvt_pk_bf16(f[4] * rstd * g[4], f[5] * rstd * g[5]); o.w = cvt_pk_bf16(f[6] * rstd * g[6], f[7] * rstd * g[7]);
      *(u32x4*)p = o; }
    { bf16* p = (bf16*)(a.ws + WS_CKV) + (size_t)R * 256 + 4 * lane; const u32x2 w = *(const u32x2*)p;
      float f[4] = {bf_lo(w.x), bf_hi(w.x), bf_lo(w.y), bf_hi(w.y)}; float ss = (f[0] * f[0] + f[1] * f[1]) + (f[2] * f[2] + f[3] * f[3]);
      const float rstd = rsqrtf(wave_sum(ss) * (1.f / 256.f) + RMS_EPS); const float* g = a.kv_norm + 4 * lane;
      u32x2 o; o.x = cvt_pk_bf16(f[0] * rstd * g[0], f[1] * rstd * g[1]); o.y = cvt_pk_bf16(f[2] * rstd * g[2], f[3] * rstd * g[3]);
      *(u32x2*)p = o; }
    if (lane < 32) { const bf16* p = (const bf16*)(a.ws + WS_KRR) + (size_t)R * 64; float x1 = __uint_as_float((unsigned)p[lane] << 16), x2 = __uint_as_float((unsigned)p[lane + 32] << 16);
      if (r >= CTXL) { const int t = r - CTXL; const float cs = ((const float*)(a.ws + WS_ROPEC))[t * 32 + lane], sn = ((const float*)(a.ws + WS_ROPES))[t * 32 + lane];
          const float y1 = x1 * cs - x2 * sn, y2 = x2 * cs + x1 * sn; x1 = y1; x2 = y2; }
      ((unsigned*)(a.ws + WS_KR))[(size_t)R * 32 + lane] = cvt_pk_bf16(x1, x2); }
}
__device__ __forceinline__ void p6_part(const Args& a, int m, int coff, int gidx) {
    const int b = m >> 13, R = b * RB + CTXL + (m & 8191);
    const size_t off = (size_t)R * 1024 + coff;
    const bf16* of = (const bf16*)(a.ws + WS_HGFF) + off; const bf16* ob = (const bf16*)(a.ws + WS_HGFB) + off; const bf16* hg = (const bf16*)(a.ws + WS_HGG) + off;
    float o[16]; float ss = 0.f;
#pragma unroll
    for (int q = 0; q < 2; ++q) { const u32x4 x = *(const u32x4*)(of + 8 * q), y = *(const u32x4*)(ob + 8 * q);
        o[8 * q + 0] = bf_lo(x.x) + bf_lo(y.x); o[8 * q + 1] = bf_hi(x.x) + bf_hi(y.x); o[8 * q + 2] = bf_lo(x.y) + bf_lo(y.y); o[8 * q + 3] = bf_hi(x.y) + bf_hi(y.y);
        o[8 * q + 4] = bf_lo(x.z) + bf_lo(y.z); o[8 * q + 5] = bf_hi(x.z) + bf_hi(y.z); o[8 * q + 6] = bf_lo(x.w) + bf_lo(y.w); o[8 * q + 7] = bf_hi(x.w) + bf_hi(y.w); }
#pragma unroll
    for (int e = 0; e < 16; ++e) ss += o[e] * o[e];
    ss += __shfl_xor(ss, 1); ss += __shfl_xor(ss, 2); ss += __shfl_xor(ss, 4);
    const float rstd = rsqrtf(ss * (1.f / 128.f) + RMS_EPS); const float* g = a.o_norm + 16 * gidx;
    bf16* dst = (bf16*)(a.ws + WS_HGFF) + off;
#pragma unroll
    for (int q = 0; q < 2; ++q) { const u32x4 gt = *(const u32x4*)(hg + 8 * q);
        const float s[8] = {bf_lo(gt.x), bf_hi(gt.x), bf_lo(gt.y), bf_hi(gt.y), bf_lo(gt.z), bf_hi(gt.z), bf_lo(gt.w), bf_hi(gt.w)}; float r[8];
#pragma unroll
        for (int e = 0; e < 8; ++e) r[e] = o[8 * q + e] * rstd * g[8 * q + e] * s[e];
        u32x4 w; w.x = cvt_pk_bf16(r[0], r[1]); w.y = cvt_pk_bf16(r[2], r[3]); w.z = cvt_pk_bf16(r[4], r[5]); w.w = cvt_pk_bf16(r[6], r[7]);
        *(u32x4*)(dst + 8 * q) = w; }
}
__device__ __forceinline__ void p9_row(const Args& a, int m, int lane) {
    const int b = m >> 13; const float* MOD = (const float*)(a.ws + WS_MOD) + b * (6 * DM);
    const bf16* ol = (const bf16*)(a.ws + WS_OUTL) + (size_t)m * DM; const float* xr = a.x + (size_t)m * DM; float* x1r = a.out + (size_t)m * DM; bf16* h2 = (bf16*)(a.ws + WS_H2) + (size_t)m * DM;
    float o[32]; float ss = 0.f;
#pragma unroll
    for (int j = 0; j < 4; ++j) { const u32x4 w = *(const u32x4*)(ol + 8 * lane + 512 * j);
        o[8 * j + 0] = bf_lo(w.x); o[8 * j + 1] = bf_hi(w.x); o[8 * j + 2] = bf_lo(w.y); o[8 * j + 3] = bf_hi(w.y); o[8 * j + 4] = bf_lo(w.z); o[8 * j + 5] = bf_hi(w.z); o[8 * j + 6] = bf_lo(w.w); o[8 * j + 7] = bf_hi(w.w); }
#pragma unroll
    for (int e = 0; e < 32; ++e) ss += o[e] * o[e];
    const float rstd1 = rsqrtf(wave_sum(ss) * (1.f / DM) + RMS_EPS);
    float ss2 = 0.f;
#pragma unroll
    for (int j = 0; j < 4; ++j) { const int c = 8 * lane + 512 * j;
#pragma unroll
        for (int q = 0; q < 2; ++q) { const f32x4 xv = *(const f32x4*)(xr + c + 4 * q), g = *(const f32x4*)(a.norm_g + DM + c + 4 * q), gt = *(const f32x4*)(MOD + 2 * DM + c + 4 * q);
#pragma unroll
            for (int e = 0; e < 4; ++e) { const float v = xv[e] + gt[e] * (o[8 * j + 4 * q + e] * rstd1 * g[e]); o[8 * j + 4 * q + e] = v; ss2 += v * v; }
            *(f32x4*)(x1r + c + 4 * q) = (f32x4){o[8 * j + 4 * q], o[8 * j + 4 * q + 1], o[8 * j + 4 * q + 2], o[8 * j + 4 * q + 3]}; } }
    const float rstd2 = rsqrtf(wave_sum(ss2) * (1.f / DM) + RMS_EPS);
#pragma unroll
    for (int j = 0; j < 4; ++j) { const int c = 8 * lane + 512 * j; float h[8];
#pragma unroll
        for (int q = 0; q < 2; ++q) { const f32x4 g = *(const f32x4*)(a.norm_g + 2 * DM + c + 4 * q), sh = *(const f32x4*)(MOD + 3 * DM + c + 4 * q), sc = *(const f32x4*)(MOD + 4 * DM + c + 4 * q);
#pragma unroll
            for (int e = 0; e < 4; ++e) h[4 * q + e] = (o[8 * j + 4 * q + e] * rstd2 * g[e]) * (1.f + sc[e]) + sh[e]; }
        u32x4 w; w.x = cvt_pk_bf16(h[0], h[1]); w.y = cvt_pk_bf16(h[2], h[3]); w.z = cvt_pk_bf16(h[4], h[5]); w.w = cvt_pk_bf16(h[6], h[7]);
        *(u32x4*)(h2 + c) = w; }
}
__device__ __forceinline__ void p12_row(const Args& a, int m, int lane) {
    const int b = m >> 13; const float* MOD = (const float*)(a.ws + WS_MOD) + b * (6 * DM);
    const bf16* yr = (const bf16*)(a.ws + WS_Y) + (size_t)m * DM; float* x1r = a.out + (size_t)m * DM;
    float o[32]; float ss = 0.f;
#pragma unroll
    for (int j = 0; j < 4; ++j) { const u32x4 w = *(const u32x4*)(yr + 8 * lane + 512 * j);
        o[8 * j + 0] = bf_lo(w.x); o[8 * j + 1] = bf_hi(w.x); o[8 * j + 2] = bf_lo(w.y); o[8 * j + 3] = bf_hi(w.y); o[8 * j + 4] = bf_lo(w.z); o[8 * j + 5] = bf_hi(w.z); o[8 * j + 6] = bf_lo(w.w); o[8 * j + 7] = bf_hi(w.w); }
#pragma unroll
    for (int e = 0; e < 32; ++e) ss += o[e] * o[e];
    const float rstd = rsqrtf(wave_sum(ss) * (1.f / DM) + RMS_EPS);
#pragma unroll
    for (int j = 0; j < 4; ++j) { const int c = 8 * lane + 512 * j;
#pragma unroll
        for (int q = 0; q < 2; ++q) { const f32x4 xv = *(const f32x4*)(x1r + c + 4 * q), g = *(const f32x4*)(a.norm_g + 3 * DM + c + 4 * q), gt = *(const f32x4*)(MOD + 5 * DM + c + 4 * q); f32x4 r;
#pragma unroll
            for (int e = 0; e < 4; ++e) r[e] = xv[e] + gt[e] * (o[8 * j + 4 * q + e] * rstd * g[e]);
            *(f32x4*)(x1r + c + 4 * q) = r; } }
}
namespace att {
constexpr int LDQ = 1536, LDK = 1024, LDO = 1024;
constexpr int SHM_V = 16384, SHM_K = 16384, SHM_KR = 8192, OFF_K = 32768, OFF_KR = 65536, OFF_WS = 81920, OFF_QR = 83968;
#define KSWZ(row, colB) ((row) * 256 + ((colB) ^ (((row) & 7) << 4)))
#define KRSWZ(row, colB) ((row) * 128 + ((colB) ^ ((((row) >> 1) & 7) << 4)))
#define SBAR() __builtin_amdgcn_sched_barrier(0)
#define ILV2() do { __builtin_amdgcn_sched_group_barrier(0x100, 8, 1); _Pragma("unroll") for (int g_ = 0; g_ < 12; ++g_) { __builtin_amdgcn_sched_group_barrier(0x008, 1, 1); __builtin_amdgcn_sched_group_barrier(0x100, 2, 1); __builtin_amdgcn_sched_group_barrier(0x002, 5, 1); } _Pragma("unroll") for (int g_ = 0; g_ < 4; ++g_) { __builtin_amdgcn_sched_group_barrier(0x008, 1, 1); __builtin_amdgcn_sched_group_barrier(0x002, 5, 1); } } while (0)
#define ILV1() do { __builtin_amdgcn_sched_group_barrier(0x100, 6, 0); _Pragma("unroll") for (int g_ = 0; g_ < 24; ++g_) { __builtin_amdgcn_sched_group_barrier(0x008, 1, 0); __builtin_amdgcn_sched_group_barrier(0x100, 1, 0); __builtin_amdgcn_sched_group_barrier(0x002, 4, 0); } } while (0)
__device__ __forceinline__ int crow(int r, int hi) { return (r & 3) + 8 * (r >> 2) + 4 * hi; }
__device__ __forceinline__ int v_st(int k, int c) { const int kk = (k & ~0xC) | ((k & 4) << 1) | ((k & 8) >> 1); return ((kk >> 3) * 4 + (c >> 5)) * 512 + ((kk & 7) * 32 + (c & 31)) * 2; }
__device__ __forceinline__ int v_rd_base(int lane) { return ((lane & 3) << 3) | (((lane >> 2) & 3) << 6) | (((lane >> 4) & 1) << 5) | (((lane >> 5) & 1) << 8); }
constexpr int v_rd_off(int d0, int ks, int half) { return d0 * 512 + ks * 4096 + half * 2048; }
template <int OFF> __device__ __forceinline__ s16x4 tr_read(int vb) { return __builtin_amdgcn_ds_read_tr16_b64_v4i16((LAS s16x4*)(unsigned)(vb + OFF)); }
template <int D0> __device__ __forceinline__ void pv_one(f32x16& od, int vb, bf16x8 pa0, bf16x8 pa1, bf16x8 pa2, bf16x8 pa3) {
  const s16x4 l0 = tr_read<v_rd_off(D0, 0, 0)>(vb), h0 = tr_read<v_rd_off(D0, 0, 1)>(vb), l1 = tr_read<v_rd_off(D0, 1, 0)>(vb), h1 = tr_read<v_rd_off(D0, 1, 1)>(vb);
  const s16x4 l2 = tr_read<v_rd_off(D0, 2, 0)>(vb), h2 = tr_read<v_rd_off(D0, 2, 1)>(vb), l3 = tr_read<v_rd_off(D0, 3, 0)>(vb), h3 = tr_read<v_rd_off(D0, 3, 1)>(vb);
#define PK(L, H) (bf16x8){L[0], L[1], L[2], L[3], H[0], H[1], H[2], H[3]}
  od = __builtin_amdgcn_mfma_f32_32x32x16_bf16(pa0, PK(l0, h0), od, 0, 0, 0);
  od = __builtin_amdgcn_mfma_f32_32x32x16_bf16(pa1, PK(l1, h1), od, 0, 0, 0);
  od = __builtin_amdgcn_mfma_f32_32x32x16_bf16(pa2, PK(l2, h2), od, 0, 0, 0);
  od = __builtin_amdgcn_mfma_f32_32x32x16_bf16(pa3, PK(l3, h3), od, 0, 0, 0);
#undef PK
}
__device__ __forceinline__ void qkt(f32x16& p0, f32x16& p1, const LAS unsigned char* Ks, const LAS unsigned char* KRs, const LAS unsigned char* QR_l, const bf16x8* qr, int r32, int hi, const float negm) {
#pragma unroll
  for (int r = 0; r < 16; ++r) { p0[r] = negm; p1[r] = negm; }
#pragma unroll
  for (int d0 = 0; d0 < 8; ++d0) { const int cb = (d0 * 16 + hi * 8) * 2;
    const bf16x8 b0 = *(const LAS bf16x8*)(Ks + KSWZ(r32, cb)); const bf16x8 b1 = *(const LAS bf16x8*)(Ks + KSWZ(32 + r32, cb));
    bf16x8 qf; if (d0 < 6) qf = qr[d0 < 6 ? d0 : 0]; else qf = *(const LAS bf16x8*)(QR_l + (d0 - 6) * 1024);
    p0 = __builtin_amdgcn_mfma_f32_32x32x16_bf16(b0, qf, p0, 0, 0, 0); p1 = __builtin_amdgcn_mfma_f32_32x32x16_bf16(b1, qf, p1, 0, 0, 0); }
#pragma unroll
  for (int d0 = 0; d0 < 4; ++d0) { const int cb = (d0 * 16 + hi * 8) * 2;
    const bf16x8 b0 = *(const LAS bf16x8*)(KRs + KRSWZ(r32, cb)); const bf16x8 b1 = *(const LAS bf16x8*)(KRs + KRSWZ(32 + r32, cb));
    const bf16x8 qf = *(const LAS bf16x8*)(QR_l + (2 + d0) * 1024);
    p0 = __builtin_amdgcn_mfma_f32_32x32x16_bf16(b0, qf, p0, 0, 0, 0); p1 = __builtin_amdgcn_mfma_f32_32x32x16_bf16(b1, qf, p1, 0, 0, 0); }
}
__device__ __forceinline__ void partialSM(f32x16& p0, f32x16& p1, float& m_reg, float& alpha, const float m_issue, const bool first = false) {
  float pmax = p0[0];
#pragma unroll
  for (int r = 1; r < 16; ++r) pmax = fmaxf(pmax, p0[r]);
#pragma unroll
  for (int r = 0; r < 16; ++r) pmax = fmaxf(pmax, p1[r]);
  { auto rr = __builtin_amdgcn_permlane32_swap(__float_as_uint(pmax), __float_as_uint(pmax), false, false); pmax = fmaxf(__uint_as_float(rr[0]), __uint_as_float(rr[1])); }
  if (first) { alpha = 1.f; m_reg = pmax + m_issue;
#pragma unroll
    for (int r = 0; r < 16; ++r) { p0[r] = p0[r] - pmax; p1[r] = p1[r] - pmax; }
    return; }
  const float delta = m_reg - m_issue;
  if (__builtin_expect(__all(pmax - delta <= 8.f) && __all(delta == 0.f), 1)) alpha = 1.f;
  else { const float smax = pmax + m_issue; const float mn = (smax - m_reg <= 8.f) ? m_reg : fmaxf(m_reg, smax); alpha = __builtin_amdgcn_exp2f(m_reg - mn); m_reg = mn; const float sh = mn - m_issue;
#pragma unroll
    for (int r = 0; r < 16; ++r) { p0[r] = p0[r] - sh; p1[r] = p1[r] - sh; } }
}
__device__ __forceinline__ void finishSM(f32x16& p0, f32x16& p1, float alpha, float& l_reg, bf16x8& pa0, bf16x8& pa1, bf16x8& pa2, bf16x8& pa3) {
#pragma unroll
  for (int r = 0; r < 16; ++r) { p0[r] = __builtin_amdgcn_exp2f(p0[r]); p1[r] = __builtin_amdgcn_exp2f(p1[r]); }
  float ps = 0.f;
#pragma unroll
  for (int r = 0; r < 16; ++r) ps += p0[r];
#pragma unroll
  for (int r = 0; r < 16; ++r) ps += p1[r];
  { auto rr = __builtin_amdgcn_permlane32_swap(__float_as_uint(ps), __float_as_uint(ps), false, false); ps = __uint_as_float(rr[0]) + __uint_as_float(rr[1]); }
  l_reg = l_reg * alpha + ps;
#define PK4(P, BASE, OUT) do { unsigned a0 = pg8::cvt_pk_bf16_safe(P[BASE + 0], P[BASE + 1]), a1 = pg8::cvt_pk_bf16_safe(P[BASE + 2], P[BASE + 3]);   \
    unsigned b0 = pg8::cvt_pk_bf16_safe(P[BASE + 4], P[BASE + 5]), b1 = pg8::cvt_pk_bf16_safe(P[BASE + 6], P[BASE + 7]);                              \
    auto r0 = __builtin_amdgcn_permlane32_swap(a0, b0, false, false); auto r1 = __builtin_amdgcn_permlane32_swap(a1, b1, false, false); \
    u32x4 w = {r0[0], r1[0], r0[1], r1[1]}; OUT = *reinterpret_cast<bf16x8*>(&w); } while (0)
  PK4(p0, 0, pa0); PK4(p0, 8, pa1); PK4(p1, 0, pa2); PK4(p1, 8, pa3);
#undef PK4
}
__device__ __forceinline__ void pv_d0(f32x16* o, int vb, bf16x8 pa0, bf16x8 pa1, bf16x8 pa2, bf16x8 pa3) {
  pv_one<0>(o[0], vb, pa0, pa1, pa2, pa3); pv_one<1>(o[1], vb, pa0, pa1, pa2, pa3); pv_one<2>(o[2], vb, pa0, pa1, pa2, pa3); pv_one<3>(o[3], vb, pa0, pa1, pa2, pa3);
}
__device__ __forceinline__ void attn_unit(const bf16* __restrict__ Qb, const bf16* __restrict__ Kh, const bf16* __restrict__ KRb, const bf16* __restrict__ Vh, bf16* __restrict__ Ob, int seq, LAS unsigned char* lds, const int wid) {
  const int lane = lane_now(), tid = wid * 64 + lane, r32 = lane & 31, hi = lane >> 5;
  LAS unsigned char* V_lds = lds; LAS unsigned char* K_lds = lds + OFF_K; LAS unsigned char* KR_lds = lds + OFF_KR;
  LAS float* wsf = (LAS float*)(lds + OFF_WS) + wid * 64; LAS float* li_l = wsf; LAS float* al_l = wsf + 32;
  float m_reg = -1e30f, l_reg = 0.f; f32x16 o[4];
#pragma unroll
  for (int d = 0; d < 4; ++d)
#pragma unroll
    for (int r = 0; r < 16; ++r) o[d][r] = 0.f;
  bf16x8 qr[6];
  const bf16* Qw = Qb + (size_t)(wid * 32 + r32) * LDQ + hi * 8;
#pragma unroll
  for (int d0 = 0; d0 < 6; ++d0) qr[d0] = *(const bf16x8*)(Qw + d0 * 16);
  LAS unsigned char* QR_l = lds + OFF_QR + (wid * 384 + lane) * 16;
#pragma unroll
  for (int d0 = 0; d0 < 6; ++d0) *(LAS bf16x8*)(QR_l + d0 * 1024) = *(const bf16x8*)(Qw + (6 + d0) * 16);
  const int sr = tid >> 4, sc = (tid & 15) * 8, vst0 = v_st(sr, sc), vst1 = v_st(32 + sr, sc);
  const int krr = tid >> 3, krc = (tid & 7) * 8;
  const int vb0 = (int)(unsigned)(uintptr_t)V_lds + v_rd_base(lane);
  bf16x8 sv0, sv1, sk0, sk1, skr;
#define SLOAD(k0) do { sv0 = *(const bf16x8*)(Vh + (size_t)((k0) + sr) * LDK + sc); sv1 = *(const bf16x8*)(Vh + (size_t)((k0) + 32 + sr) * LDK + sc); \
    sk0 = *(const bf16x8*)(Kh + (size_t)((k0) + sr) * LDK + sc); sk1 = *(const bf16x8*)(Kh + (size_t)((k0) + 32 + sr) * LDK + sc); \
    skr = *(const bf16x8*)(KRb + (size_t)((k0) + krr) * 64 + krc); } while (0)
#define SWRITE_V(b) do { *(LAS bf16x8*)(V_lds + (b) * SHM_V + vst0) = sv0; *(LAS bf16x8*)(V_lds + (b) * SHM_V + vst1) = sv1; } while (0)
#define SWRITE_K(b) do { *(LAS bf16x8*)(K_lds + (b) * SHM_K + KSWZ(sr, sc * 2)) = sk0; *(LAS bf16x8*)(K_lds + (b) * SHM_K + KSWZ(32 + sr, sc * 2)) = sk1; \
    *(LAS bf16x8*)(KR_lds + (b) * SHM_KR + KRSWZ(krr, krc * 2)) = skr; } while (0)
#define RESC(a) do { if (__any((a) < 1.f)) { if (hi == 0) al_l[r32] = (a); LDS_WAIT(); \
    _Pragma("unroll") for (int r = 0; r < 16; ++r) { const float al = al_l[crow(r, hi)]; _Pragma("unroll") for (int d = 0; d < 4; ++d) o[d][r] *= al; } } } while (0)
  f32x16 pA0, pA1, pB0, pB1; float alA, alB; bf16x8 pa0, pa1, pa2, pa3; const int NT = seq / 64;
  SLOAD(0); SWRITE_K(0); SWRITE_V(0); __syncthreads();
  qkt(pA0, pA1, K_lds, KR_lds, QR_l, qr, r32, hi, 0.f); partialSM(pA0, pA1, m_reg, alA, 0.f, true);
  SLOAD(64); SWRITE_K(1); SWRITE_V(1); __syncthreads();
  for (int j = 1; j + 1 < NT; j += 2) {
    SBAR(); const float mB_ = m_reg; qkt(pB0, pB1, K_lds + SHM_K, KR_lds + SHM_KR, QR_l, qr, r32, hi, -mB_);
    finishSM(pA0, pA1, alA, l_reg, pa0, pa1, pa2, pa3); ILV1(); SBAR();
    SLOAD((j + 1) * 64); SBAR();
    pv_d0(o, vb0, pa0, pa1, pa2, pa3); partialSM(pB0, pB1, m_reg, alB, mB_); ILV2(); SBAR();
    SWRITE_K(0); RESC(alB); __syncthreads(); SWRITE_V(0); SBAR();
    const float mA_ = m_reg; qkt(pA0, pA1, K_lds, KR_lds, QR_l, qr, r32, hi, -mA_);
    finishSM(pB0, pB1, alB, l_reg, pa0, pa1, pa2, pa3); ILV1(); SBAR();
    SLOAD((j + 2) * 64); SBAR();
    pv_d0(o, vb0 + SHM_V, pa0, pa1, pa2, pa3); partialSM(pA0, pA1, m_reg, alA, mA_); ILV2(); SBAR();
    SWRITE_K(1); RESC(alA); __syncthreads(); SWRITE_V(1); SBAR();
  }
  SBAR(); const float mT_ = m_reg; qkt(pB0, pB1, K_lds + SHM_K, KR_lds + SHM_KR, QR_l, qr, r32, hi, -mT_);
  finishSM(pA0, pA1, alA, l_reg, pa0, pa1, pa2, pa3); SBAR();
  pv_d0(o, vb0, pa0, pa1, pa2, pa3); partialSM(pB0, pB1, m_reg, alB, mT_);
  __syncthreads(); RESC(alB);
  finishSM(pB0, pB1, alB, l_reg, pa0, pa1, pa2, pa3); SBAR();
  pv_d0(o, vb0 + SHM_V, pa0, pa1, pa2, pa3);
  if (hi == 0) li_l[r32] = l_reg; LDS_WAIT();
  bf16* Ow = Ob + (size_t)(wid * 32) * LDO;
#pragma unroll
  for (int r = 0; r < 16; ++r) { const int orow = crow(r, hi); const float rl = __builtin_amdgcn_rcpf(li_l[orow]);
#pragma unroll
    for (int d0 = 0; d0 < 4; ++d0) Ow[(size_t)orow * LDO + d0 * 32 + r32] = (bf16)(pg8::cvt_pk_bf16_safe(o[d0][r] * rl, 0.f) & 0xffffu); }
  __syncthreads();
#undef SLOAD
#undef SWRITE_K
#undef SWRITE_V
#undef RESC
}
}
namespace hg {
constexpr int QD_OFF = 0, KD_OFF = 17408, KTT_OFF = 34816, HVT_OFF = 53248, SC_OFF = 71680, SEG_OFF = 80896, DEC_OFF = 84992;
__device__ __forceinline__ void scan_unit(const Args& a, int unit, LAS unsigned char* lds, const int wave) {
  const int b = unit >> 4, h = (unit >> 1) & 7, dir = unit & 1;
  const int lane = lane_now(), l15 = lane & 15, quad = lane >> 4;
  const bf16* HQ = (const bf16*)(a.ws + WS_HGQ) + h * 128; const bf16* HF = (const bf16*)(a.ws + (dir ? WS_HGFB : WS_HGFF)) + h * 128; const bf16* HV = (const bf16*)(a.ws + WS_HGI) + h * 128;
  bf16* HO = (bf16*)(a.ws + (dir ? WS_HGFB : WS_HGFF)) + h * 128;
  float lbv[2], oml[2];
#pragma unroll
  for (int e = 0; e < 2; ++e) { const int idx = dir * 1024 + h * 128 + 2 * lane + e; const float a0 = a.hgrn_lb[idx], a1 = a.hgrn_lb[2048 + idx]; lbv[e] = 1.f / (1.f + __expf(a1 - a0)); oml[e] = 1.f - lbv[e]; }
  f32x4 S[8];
#pragma unroll
  for (int d = 0; d < 8; ++d) S[d] = (f32x4){0.f, 0.f, 0.f, 0.f};
  unsigned xq[8], xf[8], xv[8];
#define CHUNK_OF(n) (dir ? ((n) < 4 ? 3 - (n) : 135 - (n)) : (n))
#define ROW_OF(c, i) ((size_t)b * RB + 64 * (c) + (dir ? 63 - (i) : (i)))
#define HLOAD(c) do { _Pragma("unroll") for (int r = 0; r < 8; ++r) { const size_t off = ROW_OF(c, 8 * wave + r) * 1024 + 2 * lane; \
      xq[r] = *(const unsigned*)(HQ + off); xf[r] = *(const unsigned*)(HF + off); xv[r] = *(const unsigned*)(HV + off); } } while (0)
  HLOAD(CHUNK_OF(0));
  for (int n = 0; n < 132; ++n) {
    const int c = CHUNK_OF(n); const bool lat = c >= 4;
    float cs[8][2], kk[8][2], qv[8][2]; unsigned hvr[8];
    { float run0 = 0.f, run1 = 0.f;
#pragma unroll
      for (int r = 0; r < 8; ++r) { const float f0 = lbv[0] + oml[0] * sigm(bf_lo(xf[r])), f1 = lbv[1] + oml[1] * sigm(bf_hi(xf[r]));
        run0 += __logf(f0); run1 += __logf(f1); cs[r][0] = run0; cs[r][1] = run1; kk[r][0] = 1.f - f0; kk[r][1] = 1.f - f1;
        qv[r][0] = bf_lo(xq[r]); qv[r][1] = bf_hi(xq[r]); hvr[r] = xv[r]; }
      *(LAS float*)(lds + SEG_OFF + (wave * 128 + 2 * lane) * 4) = run0; *(LAS float*)(lds + SEG_OFF + (wave * 128 + 2 * lane + 1) * 4) = run1; }
    if (n + 1 < 132) HLOAD(CHUNK_OF(n + 1));
    __syncthreads();
    { float pre0 = 0.f, pre1 = 0.f, tot0 = 0.f, tot1 = 0.f;
#pragma unroll
      for (int s = 0; s < 8; ++s) { const float v0 = *(LAS float*)(lds + SEG_OFF + (s * 128 + 2 * lane) * 4), v1 = *(LAS float*)(lds + SEG_OFF + (s * 128 + 2 * lane + 1) * 4);
        tot0 += v0; tot1 += v1; if (s < wave) { pre0 += v0; pre1 += v1; } }
      const float et0 = __expf(tot0), et1 = __expf(tot1);
      unsigned ktp0[4], ktp1[4], hv0[4], hv1[4];
#pragma unroll
      for (int r = 0; r < 8; r += 2) {
        float qd[2][2], kd[2][2], kt[2][2];
#pragma unroll
        for (int rr = 0; rr < 2; ++rr) { const float b0 = cs[r + rr][0] + pre0, b1 = cs[r + rr][1] + pre1;
          qd[rr][0] = qv[r + rr][0] * __expf(b0); qd[rr][1] = qv[r + rr][1] * __expf(b1);
          kd[rr][0] = kk[r + rr][0] * __expf(-b0); kd[rr][1] = kk[r + rr][1] * __expf(-b1);
          kt[rr][0] = kd[rr][0] * et0; kt[rr][1] = kd[rr][1] * et1;
          const int i = 8 * wave + r + rr;
          *(LAS unsigned*)(lds + QD_OFF + i * 272 + lane * 4) = pg8::cvt_pk_bf16_safe(qd[rr][0], qd[rr][1]);
          *(LAS unsigned*)(lds + KD_OFF + i * 272 + lane * 4) = pg8::cvt_pk_bf16_safe(kd[rr][0], kd[rr][1]); }
        ktp0[r >> 1] = pg8::cvt_pk_bf16_safe(kt[0][0], kt[1][0]); ktp1[r >> 1] = pg8::cvt_pk_bf16_safe(kt[0][1], kt[1][1]);
        hv0[r >> 1] = (hvr[r] & 0xffffu) | (hvr[r + 1] << 16); hv1[r >> 1] = (hvr[r] >> 16) | (hvr[r + 1] & 0xffff0000u); }
      *(LAS u32x4*)(lds + KTT_OFF + (2 * lane) * 144 + wave * 16) = (u32x4){ktp0[0], ktp0[1], ktp0[2], ktp0[3]};
      *(LAS u32x4*)(lds + KTT_OFF + (2 * lane + 1) * 144 + wave * 16) = (u32x4){ktp1[0], ktp1[1], ktp1[2], ktp1[3]};
      *(LAS u32x4*)(lds + HVT_OFF + (2 * lane) * 144 + wave * 16) = (u32x4){hv0[0], hv0[1], hv0[2], hv0[3]};
      *(LAS u32x4*)(lds + HVT_OFF + (2 * lane + 1) * 144 + wave * 16) = (u32x4){hv1[0], hv1[1], hv1[2], hv1[3]};
      if (wave == 0) { *(LAS float*)(lds + DEC_OFF + (2 * lane) * 4) = et0; *(LAS float*)(lds + DEC_OFF + (2 * lane + 1) * 4) = et1; } }
    __syncthreads();
    if (lat) {
#pragma unroll
      for (int e = 0; e < 2; ++e) { const int id = 2 * wave + e, it = id >> 2, st = id & 3; f32x4 acc = (f32x4){0.f, 0.f, 0.f, 0.f};
#pragma unroll
        for (int ks = 0; ks < 4; ++ks) { const bf16x8 av = *(const LAS bf16x8*)(lds + QD_OFF + (it * 16 + l15) * 272 + (ks * 32 + quad * 8) * 2);
          const bf16x8 bv = *(const LAS bf16x8*)(lds + KD_OFF + (st * 16 + l15) * 272 + (ks * 32 + quad * 8) * 2);
          acc = __builtin_amdgcn_mfma_f32_16x16x32_bf16(av, bv, acc, 0, 0, 0); }
#pragma unroll
        for (int j = 0; j < 4; ++j) { const int i = it * 16 + quad * 4 + j, s = st * 16 + l15; const float v = s <= i ? acc[j] : 0.f;
          *(LAS unsigned short*)(lds + SC_OFF + i * 144 + s * 2) = (unsigned short)(pg8::cvt_pk_bf16_safe(v, 0.f) & 0xffffu); } }
    }
    __syncthreads();
    { const int vs = 16 * wave;
      bf16x8 hvf[2];
#pragma unroll
      for (int ks = 0; ks < 2; ++ks) hvf[ks] = *(const LAS bf16x8*)(lds + HVT_OFF + (vs + l15) * 144 + (ks * 32 + quad * 8) * 2);
      if (lat) {
        bf16x8 sf[4];
#pragma unroll
        for (int ks = 0; ks < 4; ++ks) { u32x4 w; w.x = pg8::cvt_pk_bf16_safe(S[2 * ks][0], S[2 * ks][1]); w.y = pg8::cvt_pk_bf16_safe(S[2 * ks][2], S[2 * ks][3]); w.z = pg8::cvt_pk_bf16_safe(S[2 * ks + 1][0], S[2 * ks + 1][1]); w.w = pg8::cvt_pk_bf16_safe(S[2 * ks + 1][2], S[2 * ks + 1][3]);
          sf[ks] = __builtin_bit_cast(bf16x8, w); }
#pragma unroll
        for (int it = 0; it < 4; ++it) { f32x4 acc = (f32x4){0.f, 0.f, 0.f, 0.f};
#pragma unroll
          for (int ks = 0; ks < 2; ++ks) { const bf16x8 av = *(const LAS bf16x8*)(lds + SC_OFF + (it * 16 + l15) * 144 + (ks * 32 + quad * 8) * 2);
            acc = __builtin_amdgcn_mfma_f32_16x16x32_bf16(av, hvf[ks], acc, 0, 0, 0); }
#pragma unroll
          for (int ks = 0; ks < 4; ++ks) { const u32x2 lo = *(const LAS u32x2*)(lds + QD_OFF + (it * 16 + l15) * 272 + (ks * 32 + quad * 4) * 2);
            const u32x2 hi2 = *(const LAS u32x2*)(lds + QD_OFF + (it * 16 + l15) * 272 + (ks * 32 + 16 + quad * 4) * 2);
            const u32x4 w = (u32x4){lo.x, lo.y, hi2.x, hi2.y};
            acc = __builtin_amdgcn_mfma_f32_16x16x32_bf16(__builtin_bit_cast(bf16x8, w), sf[ks], acc, 0, 0, 0); }
#pragma unroll
          for (int j = 0; j < 4; ++j) { const int i = it * 16 + quad * 4 + j;
            HO[ROW_OF(c, i) * 1024 + vs + l15] = (bf16)(pg8::cvt_pk_bf16_safe(acc[j], 0.f) & 0xffffu); } }
      }
#pragma unroll
      for (int dt = 0; dt < 8; ++dt) { const f32x4 dc = *(const LAS f32x4*)(lds + DEC_OFF + (16 * dt + 4 * quad) * 4);
        f32x4 sacc = S[dt] * dc;
#pragma unroll
        for (int ks = 0; ks < 2; ++ks) { const bf16x8 av = *(const LAS bf16x8*)(lds + KTT_OFF + (dt * 16 + l15) * 144 + (ks * 32 + quad * 8) * 2);
          sacc = __builtin_amdgcn_mfma_f32_16x16x32_bf16(av, hvf[ks], sacc, 0, 0, 0); }
        S[dt] = sacc; } }
  }
#undef HLOAD
#undef CHUNK_OF
#undef ROW_OF
}
}
#define XB_TMO      128
#define XB_XCNT(j)  (256  + 64 * (j))
#define XB_XSUB(j)  (1280 + 64 * (j))
#define XB_XGEN(j)  (2304 + 64 * (j))
#define XB_TOP      3328
#define XB_TOPGEN   3392
#define XCD_BAR_WORDS 3456
#define XB_SPIN_CAP (1u << 20)
__device__ __forceinline__ unsigned xb_ld(unsigned* p)              { return __hip_atomic_load(p, __ATOMIC_RELAXED, __HIP_MEMORY_SCOPE_AGENT); }
__device__ __forceinline__ unsigned xb_add(unsigned* p, unsigned v) { return __hip_atomic_fetch_add(p, v, __ATOMIC_RELAXED, __HIP_MEMORY_SCOPE_AGENT); }
__device__ __forceinline__ unsigned xb_xcc_id() { return (unsigned)__builtin_amdgcn_s_getreg((3 << 11) | 20) & 0xFu; }
#define XB_SPIN(cond, bar) do { unsigned _sp = 0; while (cond) { __builtin_amdgcn_s_sleep(1); \
    if ((++_sp & 255u) == 0u) { if (xb_ld(&(bar)[XB_TMO])) break; if (_sp > XB_SPIN_CAP) { atomicAdd(&(bar)[XB_TMO], 1u); break; } } } } while (0)
struct XcdBarrier { unsigned* bar; unsigned x; volatile LAS unsigned* st; };
__device__ __forceinline__ XcdBarrier xcd_barrier_post(unsigned* bar, volatile LAS unsigned* st, bool leader) {
    XcdBarrier b; b.bar = bar; b.x = xb_xcc_id(); b.st = st;
    if (leader) (void)xb_add(&bar[XB_XCNT(b.x)], 1u);
    return b;
}
__device__ __forceinline__ void xcd_barrier_complete(unsigned* bar, unsigned x, unsigned& nloc, unsigned& nx) {
    const unsigned G = gridDim.x * gridDim.y * gridDim.z;
    unsigned sum, cnt, mine, sp = 0u;
    for (;;) {
        sum = 0u; cnt = 0u; mine = 0u;
#pragma unroll
        for (unsigned j = 0; j < 16; ++j) { const unsigned c = xb_ld(&bar[XB_XCNT(j)]); sum += c; cnt += (c > 0u) ? 1u : 0u; mine = (j == x) ? c : mine; }
        if (sum == G) break;
        __builtin_amdgcn_s_sleep(1);
        if ((++sp & 255u) == 0u) { if (xb_ld(&bar[XB_TMO])) break; if (sp > XB_SPIN_CAP) { atomicAdd(&bar[XB_TMO], 1u); break; } }
    }
    nloc = mine > 0u ? mine : 1u; nx = cnt > 0u ? cnt : 1u;
}
__device__ __forceinline__ void xcd_barrier(const XcdBarrier& b, bool leader) {
    asm volatile("s_waitcnt vmcnt(0)" ::: "memory");
    __syncthreads();
    if (leader) {
        unsigned* bar = b.bar;
        __builtin_amdgcn_s_waitcnt(0);
        unsigned nloc = b.st[0], nx = b.st[1];
        if (nloc == 0u) { xcd_barrier_complete(bar, b.x, nloc, nx); b.st[0] = nloc; b.st[1] = nx; }
        const unsigned old = xb_add(&bar[XB_XSUB(b.x)], 1u);
        const unsigned gen = old / nloc;
        if (old + 1u == (gen + 1u) * nloc) {
            __builtin_amdgcn_fence(__ATOMIC_RELEASE, "agent");
            asm volatile("s_waitcnt vmcnt(0)" ::: "memory");
            const unsigned og = xb_add(&bar[XB_TOP], 1u);
            const unsigned tg = og / nx;
            if (og + 1u == (tg + 1u) * nx) xb_add(&bar[XB_TOPGEN], 1u);
            else XB_SPIN(xb_ld(&bar[XB_TOPGEN]) == tg, bar);
            __builtin_amdgcn_fence(__ATOMIC_ACQUIRE, "agent");
            xb_add(&bar[XB_XGEN(b.x)], 1u);
            asm volatile("s_waitcnt vmcnt(0)" ::: "memory");
        } else {
            XB_SPIN(xb_ld(&bar[XB_XGEN(b.x)]) == gen, bar);
            __builtin_amdgcn_fence(__ATOMIC_ACQUIRE, "agent");
            asm volatile("s_waitcnt vmcnt(0)" ::: "memory");
        }
    }
    __syncthreads();
}
__device__ __forceinline__ void ffn_transpose_drain(const Args& a, LAS unsigned char* lds, unsigned* ctr, const int wave) {
    constexpr int I_FI = (DM / 64) * (2 * DFF / 32), I_FO = (DFF / 64) * (DM / 32), NIT = I_FI + I_FO;
    LAS unsigned* slot = (LAS unsigned*)(lds + LDS_MISC);
    LAS float* scr = (LAS float*)(lds + wave * 16384);
    const int lane = lane_now();
    for (;;) {
        if (wave == 0 && lane == 0) slot[1] = __hip_atomic_fetch_add(ctr, 8u, __ATOMIC_RELAXED, __HIP_MEMORY_SCOPE_AGENT);
        __syncthreads();
        const int it = (int)slot[1] + wave;
        __syncthreads();
        if (it - wave >= NIT) break;
        if (it < I_FI) transpose_item(a.w_ffn_in, DM, 2 * DFF, 2 * DFF, (bf16*)(a.ws + WS_WFIN), scr, it, lane, 3, 1.f);
        else if (it < NIT) transpose_item(a.w_ffn_out, DFF, DM, DM, (bf16*)(a.ws + WS_WFOUT), scr, it - I_FI, lane, 0, 1.f);
    }
}
__global__ void __launch_bounds__(NTHR, 2) fwd_megakernel(Args a) {
    extern __shared__ __attribute__((aligned(16))) unsigned char lds_raw[];
    LAS unsigned char* lds = (LAS unsigned char*)lds_raw;
    cg::grid_group grid = cg::this_grid();
    const int wave = __builtin_amdgcn_readfirstlane((int)threadIdx.x >> 6);
    const int G = gridDim.x, bx = blockIdx.x;
    const int gw = bx * NW + wave, NGW = G * NW;
    unsigned* ctl = (unsigned*)(a.ws + WS_CTL);
    const int lo = a.ph_lo, hi = a.ph_hi;
#ifdef PROBE_HI
#define IN(k) ((k) < PROBE_HI)
#define SEAMON(k) ((k) < PROBE_HI)
#else
#define IN(k) (lo <= (k) && (k) < hi)
#define SEAMON(k) (IN(k) && IN((k) + 1))
#endif
    { volatile LAS unsigned* st0 = (volatile LAS unsigned*)(lds + LDS_MISC + 16); if (wave == 0 && lane_now() < 2) st0[lane_now()] = 0u; }
    __syncthreads();
    XcdBarrier xbar = xcd_barrier_post(ctl + 1024, (volatile LAS unsigned*)(lds + LDS_MISC + 16), wave == 0 && lane_now() == 0);
#define SEAM(k) do { if (SEAMON(k)) { xcd_barrier(xbar, wave == 0 && lane_now() == 0); if ((k) == 0) grid.sync(); } } while (0)

    if (IN(0)) {
        const int lane = lane_now(), tid = wave * 64 + lane;
        if (bx < 192) mod_gemv_item(a, lds, bx, tid);
        LAS float* scr = (LAS float*)(lds + wave * 16384);
        constexpr int I_IN = (DM / 64) * (NINP / 32), I_UQ = (512 / 64) * (1536 / 32), I_UKV = (256 / 64) * (2048 / 32), I_BR = (1024 / 64) * (2048 / 32), I_OUT = (2048 / 64) * (2048 / 32);
        constexpr int NIT = I_IN + I_UQ + I_UKV + 2 * I_BR + I_OUT;
        for (int it = gw; it < NIT; it += NGW) { int r = it;
            if (r < I_IN) { transpose_item(a.w_in, DM, 10048, NINP, (bf16*)(a.ws + WS_WIN), scr, r, lane, 1, 1.f); continue; } r -= I_IN;
            if (r < I_UQ) { transpose_item(a.w_uq, 512, 1536, 1536, (bf16*)(a.ws + WS_WUQ), scr, r, lane, 2, QSCALE, a.q_norm); continue; } r -= I_UQ;
            if (r < I_UKV) { transpose_item(a.w_ukv, 256, 2048, 2048, (bf16*)(a.ws + WS_WUKV), scr, r, lane, 0, 1.f, a.kv_norm); continue; } r -= I_UKV;
            if (r < I_BR) { transpose_item(a.w_br_mla, 1024, 2048, 2048, (bf16*)(a.ws + WS_WBRA), scr, r, lane, 0, 1.f); continue; } r -= I_BR;
            if (r < I_BR) { transpose_item(a.w_br_hgrn, 1024, 2048, 2048, (bf16*)(a.ws + WS_WBRH), scr, r, lane, 0, 1.f); continue; } r -= I_BR;
            transpose_item(a.w_out, 2048, 2048, 2048, (bf16*)(a.ws + WS_WOUT), scr, r, lane, 0, 1.f); }
        float* RC = (float*)(a.ws + WS_ROPEC); float* RS = (float*)(a.ws + WS_ROPES);
        for (int i = bx * NTHR + tid; i < SEQ * 32; i += G * NTHR) { const int t = i >> 5, j = i & 31; const float pos = (float)(j < 16 ? (t >> 6) : (t & 63));
            const float inv = exp2f(-(float)(j & 15) * (13.287712379549449f / 16.f)); const float rev = pos * inv * 0.15915494309189535f;
            RC[i] = __builtin_amdgcn_cosf(rev); RS[i] = __builtin_amdgcn_sinf(rev); }
    }
    SEAM(0);
    if (IN(1)) { const int lane = lane_now(); for (int R = gw; R < MR; R += NGW) p1_row(a, R, lane); }
    SEAM(1);
    if (IN(2)) {
        pg8::Gemm g{(const bf16*)(a.ws + WS_H), (const bf16*)(a.ws + WS_WIN), MR, NINP, DM}; pg8::Order S; S.init(MR, NINP, G, bx, 0);
        pg8::EpiIn E{(bf16*)(a.ws + WS_CQ), (bf16*)(a.ws + WS_CKV), (bf16*)(a.ws + WS_KR), (bf16*)(a.ws + WS_HGQ), (bf16*)(a.ws + WS_HGFF), (bf16*)(a.ws + WS_HGFB), (bf16*)(a.ws + WS_HGI), (bf16*)(a.ws + WS_HGG), (bf16*)(a.ws + WS_GATE),
                     (unsigned long long*)(a.ws + WS_STAT + STAT_SQ), (unsigned long long*)(a.ws + WS_STAT + STAT_SQ) + MR, (const float*)(a.ws + WS_ROPEC), (const float*)(a.ws + WS_ROPES)};
        pg8::gemm_phase<pg8::EpiIn, pg8::Order, PG8_ALIGN, PG8_SP2>(lds, g, S, E, wave);
    }
    SEAM(2);
    if (IN(4)) {
        { pg8::Gemm g{(const bf16*)(a.ws + WS_CQ), (const bf16*)(a.ws + WS_WUQ), ML, 1536, 512}; pg8::Order S; S.init(ML, 1536, G, bx, 1);
          pg8::EpiQ E{(bf16*)(a.ws + WS_Q), (const float*)(a.ws + WS_ROPEC), (const float*)(a.ws + WS_ROPES), (const unsigned long long*)(a.ws + WS_STAT + STAT_SQ)};
          pg8::gemm_phase<pg8::EpiQ, pg8::Order, PG8_ALIGN, PG8_SP2>(lds, g, S, E, wave); }
        __syncthreads();
        { pg8::Gemm g{(const bf16*)(a.ws + WS_CKV), (const bf16*)(a.ws + WS_WUKV), MR, 2048, 256}; pg8::Order S; S.init(MR, 2048, G, bx, 0);
          pg8::EpiKV E{(bf16*)(a.ws + WS_KN), (bf16*)(a.ws + WS_VV), (const unsigned long long*)(a.ws + WS_STAT + STAT_SQ) + MR};
          pg8::gemm_phase<pg8::EpiKV, pg8::Order, PG8_ALIGN, PG8_SP2>(lds, g, S, E, wave); }
    }
    SEAM(4);
    if (IN(5)) {
        if (bx < 64) {
            hg::scan_unit(a, bx, lds, wave);
            asm volatile("s_waitcnt vmcnt(0)" ::: "memory"); __syncthreads();
            LAS unsigned* slot3 = (LAS unsigned*)(lds + LDS_MISC);
            if (wave == 0 && lane_now() == 0) { __builtin_amdgcn_fence(__ATOMIC_RELEASE, "agent"); asm volatile("s_waitcnt vmcnt(0)" ::: "memory");
                const unsigned old = __hip_atomic_fetch_add(ctl + 8 + (bx >> 1), 1u, __ATOMIC_RELAXED, __HIP_MEMORY_SCOPE_AGENT);
                __builtin_amdgcn_fence(__ATOMIC_ACQUIRE, "agent"); asm volatile("s_waitcnt vmcnt(0)" ::: "memory"); slot3[3] = old; }
            __syncthreads();
            if (slot3[3] == 1u) { const int lane = lane_now(), b = bx >> 4, h = (bx >> 1) & 7;
#pragma unroll 2
                for (int r0 = wave * 8; r0 < SEQ; r0 += 64) p6_part(a, b * SEQ + r0 + (lane >> 3), h * 128 + 16 * (lane & 7), lane & 7); }
        }
        __syncthreads();
        LAS unsigned* slot = (LAS unsigned*)(lds + LDS_MISC);
        for (;;) {
            if (wave == 0 && lane_now() == 0) slot[0] = __hip_atomic_fetch_add(ctl, 1u, __ATOMIC_RELAXED, __HIP_MEMORY_SCOPE_AGENT);
            __syncthreads();
            const unsigned u = slot[0];
            __syncthreads();
            if (u >= (unsigned)(NB * 8 * 32)) break;
            const int qb = u & 31, h = (u >> 5) & 7, b = u >> 8;
            const size_t R0 = (size_t)b * RB, m0 = (size_t)b * SEQ + qb * 256;
            att::attn_unit((const bf16*)(a.ws + WS_Q) + m0 * 1536 + h * 192, (const bf16*)(a.ws + WS_KN) + R0 * 1024 + h * 128, (const bf16*)(a.ws + WS_KR) + R0 * 64,
                           (const bf16*)(a.ws + WS_VV) + R0 * 1024 + h * 128, (bf16*)(a.ws + WS_ATTO) + m0 * 1024 + h * 128, RB, lds, wave);
        }
        __syncthreads();
        ffn_transpose_drain(a, lds, ctl + 2, wave);
    }
    SEAM(5);
    if (IN(6)) {
        ffn_transpose_drain(a, lds, ctl + 2, wave);
        __syncthreads();
        pg8::Gemm g{(const bf16*)(a.ws + WS_ATTO), (const bf16*)(a.ws + WS_WBRA), ML, DM, 1024}; pg8::Order S; S.init(ML, DM, G, bx, 0);
        pg8::EpiGate<false> E{(bf16*)(a.ws + WS_T), (const bf16*)(a.ws + WS_GATE), nullptr, 0, 0};
        pg8::gemm_phase<pg8::EpiGate<false>, pg8::Order, PG8_ALIGN, PG8_SP2>(lds, g, S, E, wave);
        asm volatile("s_waitcnt vmcnt(0)" ::: "memory"); __syncthreads();
    }
    if (IN(7)) {
        pg8::Gemm g{(const bf16*)(a.ws + WS_HGFF), (const bf16*)(a.ws + WS_WBRH), ML, DM, 1024}; pg8::Order S; S.init(ML, DM, G, bx, 1);
        pg8::EpiGate<true> E{(bf16*)(a.ws + WS_M1), (const bf16*)(a.ws + WS_GATE), (const bf16*)(a.ws + WS_T), 2048, 1};
        pg8::gemm_phase<pg8::EpiGate<true>, pg8::Order, PG8_ALIGN, PG8_SP2>(lds, g, S, E, wave);
    }
    SEAM(7);
    if (IN(8)) {
        unsigned long long* ST = (unsigned long long*)(a.ws + WS_STAT); unsigned* CN = (unsigned*)(a.ws + WS_STAT + 3 * 262144);
        pg8::Gemm g{(const bf16*)(a.ws + WS_M1), (const bf16*)(a.ws + WS_WOUT), ML, DM, DM}; pg8::OrderPanel S; S.init(G, bx);
        pg8::EpiRes1 E{a.x, a.out, (bf16*)(a.ws + WS_H2), (const float*)(a.ws + WS_MOD), a.norm_g, ST, ST + 32768, CN, CN + 128 * 64};
        pg8::gemm_phase<pg8::EpiRes1, pg8::OrderPanel, PG8_ALIGN, PG8_SP2>(lds, g, S, E, wave);
    }
    SEAM(8);
    if (IN(10)) {
        pg8::Gemm g{(const bf16*)(a.ws + WS_H2), (const bf16*)(a.ws + WS_WFIN), ML, 2 * DFF, DM}; pg8::Order S; S.init(ML, 2 * DFF, G, bx, 0);
        pg8::EpiSwiGLU E{(bf16*)(a.ws + WS_ACT)};
        pg8::gemm_phase<pg8::EpiSwiGLU, pg8::Order, PG8_ALIGN, PG8_SP2>(lds, g, S, E, wave);
    }
    SEAM(10);
    if (IN(11)) {
        unsigned long long* ST = (unsigned long long*)(a.ws + WS_STAT); unsigned* CN = (unsigned*)(a.ws + WS_STAT + 3 * 262144);
        pg8::Gemm g{(const bf16*)(a.ws + WS_ACT), (const bf16*)(a.ws + WS_WFOUT), ML, DM, DFF}; pg8::OrderPanel S; S.init(G, bx);
        pg8::EpiRes2 E{a.out, (const float*)(a.ws + WS_MOD), a.norm_g, ST + 2 * 32768, CN + 2 * 128 * 64};
        pg8::gemm_phase<pg8::EpiRes2, pg8::OrderPanel, PG8_ALIGN, PG8_SP2>(lds, g, S, E, wave);
    }
#ifdef PROBE_HI
    {
        const size_t offs[] = {PROBE_OFFS}; const size_t lens[] = {PROBE_LENS};
        constexpr int NBUF = sizeof(offs) / sizeof(offs[0]);
        for (size_t i = (size_t)bx * NTHR + wave * 64 + lane_now(); i < (size_t)ML * DM; i += (size_t)G * NTHR) { float acc = 0.f;
            for (int q = 0; q < NBUF; ++q) { const bf16* bp = (const bf16*)(a.ws + offs[q]); const float v = __uint_as_float((unsigned)bp[i % lens[q]] << 16); acc += (fabsf(v) < 1e30f) ? v : 1000.f; }
            a.out[i] = acc; }
    }
#endif
#undef IN
#undef SEAM
}

extern "C" void kernel_launch(void* const* d_in, const int* in_sizes, int n_in, void* d_out, int out_size, void* d_ws, size_t ws_size, hipStream_t stream) {
    static int grid = 0;
    if (grid == 0) {
        if (n_in != 19 || in_sizes[0] != ML * DM || out_size != ML * DM || ws_size < WS_END) { fprintf(stderr, "kernel_launch: shape/workspace mismatch (n_in %d, in0 %d, out %d, ws %zu < %zu)\n", n_in, n_in > 0 ? in_sizes[0] : -1, out_size, ws_size, (size_t)WS_END); grid = -1; return; }
        int dev = 0, cus = 0, per_cu = 0;
        if (hipGetDevice(&dev) != hipSuccess || hipDeviceGetAttribute(&cus, hipDeviceAttributeMultiprocessorCount, dev) != hipSuccess) { grid = -1; return; }
        if (hipFuncSetAttribute((const void*)fwd_megakernel, hipFuncAttributeMaxDynamicSharedMemorySize, LDS_BYTES) != hipSuccess) { fprintf(stderr, "kernel_launch: hipFuncSetAttribute failed\n"); grid = -1; return; }
        if (hipOccupancyMaxActiveBlocksPerMultiprocessor(&per_cu, (const void*)fwd_megakernel, NTHR, LDS_BYTES) != hipSuccess || per_cu < 1) { fprintf(stderr, "kernel_launch: occupancy query gave %d\n", per_cu); per_cu = 1; }
        (void)hipGetLastError();
        grid = cus * per_cu;
    }
    if (grid < 0) return;
    Args a{};
    const float** p = (const float**)&a;
    for (int i = 0; i < 19; ++i) p[i] = (const float*)d_in[i];
    a.out = (float*)d_out; a.ws = (unsigned char*)d_ws; a.ph_lo = 0; a.ph_hi = 13;

    if (hipMemsetAsync((char*)d_ws + WS_CTL, 0, WS_STAT + STAT_BYTES, stream) != hipSuccess) { fprintf(stderr, "kernel_launch: memset failed\n"); return; }
    void* args[] = {&a};
    hipError_t e = hipLaunchCooperativeKernel((const void*)fwd_megakernel, dim3(grid), dim3(NTHR), args, LDS_BYTES, stream);
    if (e != hipSuccess) fprintf(stderr, "cooperative launch failed: %s (grid %d)\n", hipGetErrorString(e), grid);
}
```

```cpp
#include <hip/hip_runtime.h>
#include <hip/hip_cooperative_groups.h>
#include <cstdio>
#include <cstdint>
namespace cg = cooperative_groups;
namespace pg8 {
#define PG8_LAS __attribute__((address_space(3)))
typedef unsigned short bf16_t;
typedef short bf16x8 __attribute__((ext_vector_type(8)));
typedef float f32x4 __attribute__((ext_vector_type(4)));
typedef unsigned u32x4 __attribute__((ext_vector_type(4)));
constexpr int BM = 256, BK = 64, HALF = 128, HTB = HALF * BK * 2  , STAGE_BYTES = 8 * HTB, NXCD = 8, WGM = 8;

__host__ __device__ __forceinline__ int lds_byte(int r, int c) { const int st = (r >> 4) * 2 + (c >> 5), rr = r & 15, cc = c & 31, ob = rr * 64 + cc * 2; return st * 1024 + (ob ^ (((ob >> 9) & 1) << 5)); }
__host__ __device__ __forceinline__ void stage_rc(int b, int& R, int& C) { const int st = b / 1024, sb = b % 1024, swz = sb ^ (((sb >> 9) & 1) << 5); R = (st >> 1) * 16 + swz / 64; C = (st & 1) * 32 + (swz % 64) / 2; }
__host__ __device__ __forceinline__ int perm32(int rho) { const int n = rho >> 4, i = rho & 15; return 8 * (i >> 2) + 4 * n + (i & 3); }

struct Unit { int pm, pn; };
struct Gemm { const bf16_t* A; const bf16_t* Bt; int M, N, K; };

struct StaticOrder {
    int nM, nN, nwg, G, c;
    __host__ __device__ void init(int M, int N, int G_, int c_) { nM = M / BM; nN = N / BM; nwg = nM * nN; G = G_; c = c_; }
    __host__ __device__ bool next(int i, Unit& u) const {
        const long L = (long)i * G + c; if (L >= nwg) return false;
        int wgid = (int)L; { const int q = nwg / NXCD, r = nwg % NXCD, xcd = wgid % NXCD, off = wgid / NXCD; wgid = (xcd < r ? xcd * (q + 1) : r * (q + 1) + (xcd - r) * q) + off; }
        const int nig = WGM * nN, gid = wgid / nig, fm = gid * WGM, gsz = (nM - fm) < WGM ? (nM - fm) : WGM;
        u.pm = fm + ((wgid % nig) % gsz); u.pn = (wgid % nig) / gsz; return true;
    }
    __device__ __forceinline__ void a_ready(const Unit&) const {}
    __device__ __forceinline__ void done(const Unit&) const {}
};

typedef __bf16 bf16x2_t __attribute__((ext_vector_type(2)));
typedef float f32x2_t __attribute__((ext_vector_type(2)));
__device__ __forceinline__ unsigned cvt_pk_bf16_safe(float lo, float hi) { const f32x2_t f = {lo, hi}; const bf16x2_t r = __builtin_convertvector(f, bf16x2_t); return __builtin_bit_cast(unsigned, r); }
__device__ __forceinline__ unsigned cvt_pk_bf16(float lo, float hi) { unsigned r; asm volatile("v_cvt_pk_bf16_f32 %0, %1, %2" : "=v"(r) : "v"(lo), "v"(hi)); return r; }
__device__ __forceinline__ u32x4 pack8s(const f32x4 v0, const f32x4 v1) { u32x4 w; w.x = cvt_pk_bf16_safe(v0[0], v0[1]); w.y = cvt_pk_bf16_safe(v0[2], v0[3]); w.z = cvt_pk_bf16_safe(v1[0], v1[1]); w.w = cvt_pk_bf16_safe(v1[2], v1[3]); return w; }
__device__ __forceinline__ u32x4 pack8(const f32x4 v0, const f32x4 v1) { u32x4 w; w.x = cvt_pk_bf16(v0[0], v0[1]); w.y = cvt_pk_bf16(v0[2], v0[3]); w.z = cvt_pk_bf16(v1[0], v1[1]); w.w = cvt_pk_bf16(v1[2], v1[3]); return w; }
__device__ __forceinline__ float bf_lo(unsigned w) { return __uint_as_float(w << 16); }
__device__ __forceinline__ float bf_hi(unsigned w) { return __uint_as_float(w & 0xffff0000u); }
__device__ __forceinline__ float sigm(float x) { return __builtin_amdgcn_rcpf(1.0f + __expf(-x)); }

struct Order {
    int nM, nN, nwg, G, c, lat;
    __device__ void init(int M, int N, int G_, int c_, int lat_) { nM = M / BM; nN = N / BM; nwg = nM * nN; G = G_; c = c_; lat = lat_; }
    __device__ bool next(int i, Unit& u) const {
        const long L = (long)i * G + c; if (L >= nwg) return false;
        int wgid = (int)L; { const int q = nwg / NXCD, r = nwg % NXCD, xcd = wgid % NXCD, off = wgid / NXCD; wgid = (xcd < r ? xcd * (q + 1) : r * (q + 1) + (xcd - r) * q) + off; }
        const int nig = WGM * nN, gid = wgid / nig, fm = gid * WGM, gsz = (nM - fm) < WGM ? (nM - fm) : WGM;
        int pm = fm + ((wgid % nig) % gsz); u.pn = (wgid % nig) / gsz;
        if (lat) pm = pm + (pm >> 5) + 1;
        u.pm = pm; return true;
    }
    __device__ __forceinline__ void a_ready(const Unit&) const {}
    __device__ __forceinline__ void done(const Unit&) const {}
};

struct EpiIn {
    static constexpr bool PERM = true, AFTER_DRAIN = false;
    bf16_t *CQ, *CKV, *KRR, *HGq, *HGff, *HGfb, *HGi, *HGg, *GATE;
    unsigned long long *SQ, *SKV; const float *RC, *RS;
    __device__ __forceinline__ void operator()(const f32x4 (&acc)[2][2][4][2], const Unit& u, int wr, int wc, int fr, int fq) const {
        const int pn = u.pn, pm = u.pm, bt = pm / 33; const bool isctx = (pm - bt * 33) == 0;
        if (pn < 3) {
            unsigned long long* S = pn < 2 ? SQ : SKV;
#pragma unroll
            for (int ai = 0; ai < 2; ++ai)
#pragma unroll
                for (int m = 0; m < 4; ++m) { float sq = 0.f;
#pragma unroll
                    for (int bj = 0; bj < 2; ++bj)
#pragma unroll
                        for (int n = 0; n < 2; ++n) { const f32x4 v = acc[ai][bj][m][n]; sq += (v[0] * v[0] + v[1] * v[1]) + (v[2] * v[2] + v[3] * v[3]); }
                    sq += __shfl_xor(sq, 16); sq += __shfl_xor(sq, 32);
                    if (fq == 0) (void)__hip_atomic_fetch_add(S + pm * BM + wr * 64 + fr + ai * HALF + m * 16, (unsigned long long)(sq * 4294967296.f), __ATOMIC_RELAXED, __HIP_MEMORY_SCOPE_AGENT); }
        }
        if (pn == 3) {
            const int lc = wc * 32 + 8 * fq; if (lc >= 64) return;
            const int i0 = lc >> 1, tt = pm - 33 * bt - 1;
#pragma unroll
            for (int ai = 0; ai < 2; ++ai)
#pragma unroll
                for (int m = 0; m < 4; ++m) { const int rl = wr * 64 + fr + ai * HALF + m * 16; f32x4 v0 = acc[ai][0][m][0], v1 = acc[ai][0][m][1];
                    if (!isctx) { const int t = tt * BM + rl; const f32x4 cs = *(const f32x4*)(RC + t * 32 + i0), sn = *(const f32x4*)(RS + t * 32 + i0); f32x4 x, y;
                        x[0] = v0[0] * cs[0] - v0[1] * sn[0]; x[1] = v0[1] * cs[0] + v0[0] * sn[0]; x[2] = v0[2] * cs[1] - v0[3] * sn[1]; x[3] = v0[3] * cs[1] + v0[2] * sn[1];
                        y[0] = v1[0] * cs[2] - v1[1] * sn[2]; y[1] = v1[1] * cs[2] + v1[0] * sn[2]; y[2] = v1[2] * cs[3] - v1[3] * sn[3]; y[3] = v1[3] * cs[3] + v1[2] * sn[3];
                        v0 = x; v1 = y; }
                    *(u32x4*)(KRR + (size_t)(pm * BM + rl) * 64 + lc) = pack8(v0, v1); }
            return; }
        bf16_t* base; int ldc, colt, act = 0, rowt = pm * BM, maxcol = 256;
        if (pn < 2) { base = CQ; ldc = 512; colt = pn * 256; }
        else if (pn == 2) { base = CKV; ldc = 256; colt = 0; }
        else if (pn == 3) { base = KRR; ldc = 64; colt = 0; maxcol = 64; }
        else if (pn < 8) { base = HGq; ldc = 1024; colt = (pn - 4) * 256; act = 1; }
        else if (pn < 12) { base = HGff; ldc = 1024; colt = (pn - 8) * 256; }
        else if (pn < 16) { base = HGfb; ldc = 1024; colt = (pn - 12) * 256; }
        else if (pn < 20) { base = HGi; ldc = 1024; colt = (pn - 16) * 256; }
        else if (pn < 24) { if (isctx) return; base = HGg; ldc = 1024; colt = (pn - 20) * 256; act = 2; }
        else { if (isctx) return; base = GATE; ldc = 4096; colt = (pn - 24) * 256; act = 3; rowt = (pm - bt - 1) * BM; }
        const int row0 = rowt + wr * 64 + fr, lc0 = wc * 32 + 8 * fq;
#pragma unroll
        for (int ai = 0; ai < 2; ++ai)
#pragma unroll
            for (int m = 0; m < 4; ++m) { bf16_t* rowp = base + (size_t)(row0 + ai * HALF + m * 16) * ldc + colt + lc0;
#pragma unroll
                for (int bj = 0; bj < 2; ++bj) { if (lc0 + bj * HALF >= maxcol) continue;
                    f32x4 v0 = acc[ai][bj][m][0], v1 = acc[ai][bj][m][1];
                    if (act == 1) {
#pragma unroll
                        for (int e = 0; e < 4; ++e) { v0[e] = v0[e] * sigm(v0[e]) * 0.08838834764831845f; v1[e] = v1[e] * sigm(v1[e]) * 0.08838834764831845f; } }
                    else if (act == 2) {
#pragma unroll
                        for (int e = 0; e < 4; ++e) { v0[e] = v0[e] * sigm(v0[e]); v1[e] = v1[e] * sigm(v1[e]); } }
                    else if (act == 3) {
#pragma unroll
                        for (int e = 0; e < 4; ++e) { v0[e] = sigm(v0[e]); v1[e] = sigm(v1[e]); } }
                    *(u32x4*)(rowp + bj * HALF) = pack8(v0, v1); } }
    }
};
struct EpiQ {
    static constexpr bool PERM = true, AFTER_DRAIN = false;
    bf16_t* Q; const float* RC; const float* RS; const unsigned long long* SQ;
    __device__ __forceinline__ void operator()(const f32x4 (&acc)[2][2][4][2], const Unit& u, int wr, int wc, int fr, int fq) const {
        const int pm = u.pm, bt = pm / 33, mt = pm - bt - 1, tt = pm - 33 * bt - 1;
        const int row0 = wr * 64 + fr;
#pragma unroll
        for (int bj = 0; bj < 2; ++bj) {
            const int c0 = u.pn * BM + bj * HALF + wc * 32 + 8 * fq; const int cm = c0 % 192; const bool rope = cm >= 128; const int j0 = (cm - 128) >> 1;
#pragma unroll
            for (int ai = 0; ai < 2; ++ai)
#pragma unroll
                for (int m = 0; m < 4; ++m) { const int rl = row0 + ai * HALF + m * 16;
                    const float rs = rsqrtf((float)__hip_atomic_load(SQ + pm * BM + rl, __ATOMIC_RELAXED, __HIP_MEMORY_SCOPE_AGENT) * (2.3283064365386963e-10f / 512.f) + 1e-6f);
                    f32x4 v0 = acc[ai][bj][m][0] * rs, v1 = acc[ai][bj][m][1] * rs;
                    if (rope) { const int t = tt * BM + rl; const f32x4 cs = *(const f32x4*)(RC + t * 32 + j0), sn = *(const f32x4*)(RS + t * 32 + j0);
                        f32x4 a, b;
                        a[0] = v0[0] * cs[0] - v0[1] * sn[0]; a[1] = v0[1] * cs[0] + v0[0] * sn[0]; a[2] = v0[2] * cs[1] - v0[3] * sn[1]; a[3] = v0[3] * cs[1] + v0[2] * sn[1];
                        b[0] = v1[0] * cs[2] - v1[1] * sn[2]; b[1] = v1[1] * cs[2] + v1[0] * sn[2]; b[2] = v1[2] * cs[3] - v1[3] * sn[3]; b[3] = v1[3] * cs[3] + v1[2] * sn[3];
                        v0 = a; v1 = b; }
                    *(u32x4*)(Q + (size_t)(mt * BM + rl) * 1536 + c0) = pack8(v0, v1); } }
    }
};
struct EpiKV {
    static constexpr bool PERM = true, AFTER_DRAIN = false;
    bf16_t *KN, *VV; const unsigned long long* SKV;
    __device__ __forceinline__ void operator()(const f32x4 (&acc)[2][2][4][2], const Unit& u, int wr, int wc, int fr, int fq) const {
        const int row0 = u.pm * BM + wr * 64 + fr, col0 = u.pn * 128 + wc * 32 + 8 * fq;
#pragma unroll
        for (int ai = 0; ai < 2; ++ai)
#pragma unroll
            for (int m = 0; m < 4; ++m) { const int r = row0 + ai * HALF + m * 16; const size_t off = (size_t)r * 1024 + col0;
                const float rs = rsqrtf((float)__hip_atomic_load(SKV + r, __ATOMIC_RELAXED, __HIP_MEMORY_SCOPE_AGENT) * (2.3283064365386963e-10f / 256.f) + 1e-6f);
                *(u32x4*)(KN + off) = pack8(acc[ai][0][m][0] * rs, acc[ai][0][m][1] * rs);
                *(u32x4*)(VV + off) = pack8(acc[ai][1][m][0] * rs, acc[ai][1][m][1] * rs); }
    }
};
template <bool ADD> struct EpiGate {
    static constexpr bool PERM = true, AFTER_DRAIN = false;
    bf16_t* O; const bf16_t* G; const bf16_t* A; int goff, lat;
    __device__ __forceinline__ void operator()(const f32x4 (&acc)[2][2][4][2], const Unit& u, int wr, int wc, int fr, int fq) const {
        const int row0 = (lat ? u.pm - u.pm / 33 - 1 : u.pm) * BM + wr * 64 + fr, col0 = u.pn * BM + wc * 32 + 8 * fq;
#pragma unroll
        for (int ai = 0; ai < 2; ++ai)
#pragma unroll
            for (int m = 0; m < 4; ++m) { const size_t r = (size_t)(row0 + ai * HALF + m * 16);
#pragma unroll
                for (int bj = 0; bj < 2; ++bj) { const int c = col0 + bj * HALF; const u32x4 g = *(const u32x4*)(G + r * 4096 + goff + c);
                    f32x4 v0 = acc[ai][bj][m][0], v1 = acc[ai][bj][m][1];
                    v0[0] *= bf_lo(g.x); v0[1] *= bf_hi(g.x); v0[2] *= bf_lo(g.y); v0[3] *= bf_hi(g.y); v1[0] *= bf_lo(g.z); v1[1] *= bf_hi(g.z); v1[2] *= bf_lo(g.w); v1[3] *= bf_hi(g.w);
                    if (ADD) { const u32x4 a = *(const u32x4*)(A + r * 2048 + c);
                        v0[0] += bf_lo(a.x); v0[1] += bf_hi(a.x); v0[2] += bf_lo(a.y); v0[3] += bf_hi(a.y); v1[0] += bf_lo(a.z); v1[1] += bf_hi(a.z); v1[2] += bf_lo(a.w); v1[3] += bf_hi(a.w); }
                    *(u32x4*)(O + r * 2048 + c) = pack8(v0, v1); } }
    }
};
struct EpiPlain {
    static constexpr bool PERM = true, AFTER_DRAIN = false;
    bf16_t* O; int ldc;
    __device__ __forceinline__ void operator()(const f32x4 (&acc)[2][2][4][2], const Unit& u, int wr, int wc, int fr, int fq) const {
        const int row0 = u.pm * BM + wr * 64 + fr, col0 = u.pn * BM + wc * 32 + 8 * fq;
#pragma unroll
        for (int ai = 0; ai < 2; ++ai)
#pragma unroll
            for (int m = 0; m < 4; ++m) { bf16_t* rowp = O + (size_t)(row0 + ai * HALF + m * 16) * ldc + col0;
#pragma unroll
                for (int bj = 0; bj < 2; ++bj) *(u32x4*)(rowp + bj * HALF) = pack8(acc[ai][bj][m][0], acc[ai][bj][m][1]); }
    }
};
struct OrderPanel {
    int G, c;
    __device__ void init(int G_, int c_) { G = G_; c = c_; }
    __device__ bool next(int i, Unit& u) const {
        const int ppx = G >> 6;
        if (ppx == 0 || (G & 63)) return false;
        const int x = c & 7, j = c >> 3, panel = (i * 8 + x) * ppx + (j >> 3);
        if (panel >= 128) return false;
        u.pm = panel; u.pn = j & 7; return true;
    }
    __device__ __forceinline__ void a_ready(const Unit&) const {}
    __device__ __forceinline__ void done(const Unit&) const {}
};
__device__ __forceinline__ void panel_publish(unsigned long long* S, unsigned* cnt, const float (&ss)[2][4], int row0, int fr, int fq) {
    if (fq == 0) {
#pragma unroll
        for (int ai = 0; ai < 2; ++ai)
#pragma unroll
            for (int m = 0; m < 4; ++m) (void)__hip_atomic_fetch_add(S + row0 + ai * HALF + m * 16, (unsigned long long)(ss[ai][m] * 4294967296.f), __ATOMIC_RELAXED, __HIP_MEMORY_SCOPE_AGENT);
    }
    asm volatile("s_waitcnt vmcnt(0)" ::: "memory");
    if (fr == 0 && fq == 0) { (void)__hip_atomic_fetch_add(cnt, 1u, __ATOMIC_RELAXED, __HIP_MEMORY_SCOPE_AGENT);
        unsigned sp = 0; while (__hip_atomic_load(cnt, __ATOMIC_RELAXED, __HIP_MEMORY_SCOPE_AGENT) < 64u) { __builtin_amdgcn_s_sleep(1); if (++sp > (1u << 22)) break; } }
    asm volatile("" ::: "memory");
}
__device__ __forceinline__ float panel_rstd(const unsigned long long* S, int row) {
    const unsigned long long v = __hip_atomic_load(S + row, __ATOMIC_RELAXED, __HIP_MEMORY_SCOPE_AGENT);
    return rsqrtf((float)v * (2.3283064365386963e-10f / 2048.f) + 1e-6f);
}
struct EpiRes1 {
    static constexpr bool PERM = true, AFTER_DRAIN = false;
    const float* X; float* X1; bf16_t* H2; const float* MOD; const float* NG; unsigned long long *S1, *S2; unsigned *C1, *C2;
    __device__ __forceinline__ void operator()(f32x4 (&acc)[2][2][4][2], const Unit& u, int wr, int wc, int fr, int fq) const {
        const int row0 = u.pm * BM + wr * 64 + fr, col0 = u.pn * BM + wc * 32 + 8 * fq; const float* mod = MOD + (u.pm >> 5) * 12288;
        float ss[2][4];
#pragma unroll
        for (int ai = 0; ai < 2; ++ai)
#pragma unroll
            for (int m = 0; m < 4; ++m) { float s = 0.f;
#pragma unroll
                for (int bj = 0; bj < 2; ++bj)
#pragma unroll
                    for (int n = 0; n < 2; ++n) { const f32x4 v = acc[ai][bj][m][n]; s += (v[0] * v[0] + v[1] * v[1]) + (v[2] * v[2] + v[3] * v[3]); }
                s += __shfl_xor(s, 16); s += __shfl_xor(s, 32); ss[ai][m] = s; }
        panel_publish(S1, C1 + 64 * u.pm, ss, row0, fr, fq);
        f32x4 g1[2][2], gt[2][2];
#pragma unroll
        for (int bj = 0; bj < 2; ++bj)
#pragma unroll
            for (int n = 0; n < 2; ++n) { const int c = col0 + bj * HALF + 4 * n; g1[bj][n] = *(const f32x4*)(NG + 2048 + c); gt[bj][n] = *(const f32x4*)(mod + 2 * 2048 + c); }
#pragma unroll
        for (int ai = 0; ai < 2; ++ai)
#pragma unroll
            for (int m = 0; m < 4; ++m) { const int r = row0 + ai * HALF + m * 16; const float rs = panel_rstd(S1, r); float s = 0.f;
#pragma unroll
                for (int bj = 0; bj < 2; ++bj)
#pragma unroll
                    for (int n = 0; n < 2; ++n) { const size_t off = (size_t)r * 2048 + col0 + bj * HALF + 4 * n; const f32x4 xv = *(const f32x4*)(X + off);
                        const f32x4 v = xv + gt[bj][n] * (acc[ai][bj][m][n] * rs * g1[bj][n]); acc[ai][bj][m][n] = v; *(f32x4*)(X1 + off) = v;
                        s += (v[0] * v[0] + v[1] * v[1]) + (v[2] * v[2] + v[3] * v[3]); }
                s += __shfl_xor(s, 16); s += __shfl_xor(s, 32); ss[ai][m] = s; }
        panel_publish(S2, C2 + 64 * u.pm, ss, row0, fr, fq);
#pragma unroll
        for (int bj = 0; bj < 2; ++bj) { f32x4 g2[2], sh[2], sc[2];
#pragma unroll
            for (int n = 0; n < 2; ++n) { const int c = col0 + bj * HALF + 4 * n; g2[n] = *(const f32x4*)(NG + 2 * 2048 + c); sh[n] = *(const f32x4*)(mod + 3 * 2048 + c); sc[n] = *(const f32x4*)(mod + 4 * 2048 + c) + 1.0f; }
#pragma unroll
            for (int ai = 0; ai < 2; ++ai)
#pragma unroll
                for (int m = 0; m < 4; ++m) { const int r = row0 + ai * HALF + m * 16; const float rs = panel_rstd(S2, r);
                    const f32x4 h0 = (acc[ai][bj][m][0] * rs * g2[0]) * sc[0] + sh[0], h1 = (acc[ai][bj][m][1] * rs * g2[1]) * sc[1] + sh[1];
                    *(u32x4*)(H2 + (size_t)r * 2048 + col0 + bj * HALF) = pack8(h0, h1); } }
    }
};
struct EpiRes2 {
    static constexpr bool PERM = true, AFTER_DRAIN = false;
    float* OUT; const float* MOD; const float* NG; unsigned long long* S3; unsigned* C3;
    __device__ __forceinline__ void operator()(f32x4 (&acc)[2][2][4][2], const Unit& u, int wr, int wc, int fr, int fq) const {
        const int row0 = u.pm * BM + wr * 64 + fr, col0 = u.pn * BM + wc * 32 + 8 * fq; const float* mod = MOD + (u.pm >> 5) * 12288;
        float ss[2][4];
#pragma unroll
        for (int ai = 0; ai < 2; ++ai)
#pragma unroll
            for (int m = 0; m < 4; ++m) { float s = 0.f;
#pragma unroll
                for (int bj = 0; bj < 2; ++bj)
#pragma unroll
                    for (int n = 0; n < 2; ++n) { const f32x4 v = acc[ai][bj][m][n]; s += (v[0] * v[0] + v[1] * v[1]) + (v[2] * v[2] + v[3] * v[3]); }
                s += __shfl_xor(s, 16); s += __shfl_xor(s, 32); ss[ai][m] = s; }
        panel_publish(S3, C3 + 64 * u.pm, ss, row0, fr, fq);
        f32x4 g3[2][2], gt[2][2];
#pragma unroll
        for (int bj = 0; bj < 2; ++bj)
#pragma unroll
            for (int n = 0; n < 2; ++n) { const int c = col0 + bj * HALF + 4 * n; g3[bj][n] = *(const f32x4*)(NG + 3 * 2048 + c); gt[bj][n] = *(const f32x4*)(mod + 5 * 2048 + c); }
#pragma unroll
        for (int ai = 0; ai < 2; ++ai)
#pragma unroll
            for (int m = 0; m < 4; ++m) { const int r = row0 + ai * HALF + m * 16; const float rs = panel_rstd(S3, r);
#pragma unroll
                for (int bj = 0; bj < 2; ++bj)
#pragma unroll
                    for (int n = 0; n < 2; ++n) { const size_t off = (size_t)r * 2048 + col0 + bj * HALF + 4 * n; const f32x4 xv = *(const f32x4*)(OUT + off);
                        *(f32x4*)(OUT + off) = xv + gt[bj][n] * (acc[ai][bj][m][n] * rs * g3[bj][n]); } }
    }
};
struct EpiSwiGLU {
    static constexpr bool PERM = true, AFTER_DRAIN = false;
    bf16_t* O;
    __device__ __forceinline__ void operator()(const f32x4 (&acc)[2][2][4][2], const Unit& u, int wr, int wc, int fr, int fq) const {
        typedef unsigned u32x2v __attribute__((ext_vector_type(2)));
        const int row0 = u.pm * BM + wr * 64 + fr, col0 = u.pn * 128 + wc * 16 + 4 * fq;
#pragma unroll
        for (int ai = 0; ai < 2; ++ai)
#pragma unroll
            for (int m = 0; m < 4; ++m) { bf16_t* rowp = O + (size_t)(row0 + ai * HALF + m * 16) * 5632 + col0;
#pragma unroll
                for (int bj = 0; bj < 2; ++bj) { const f32x4 a = acc[ai][bj][m][0], b = acc[ai][bj][m][1]; f32x4 r;
#pragma unroll
                    for (int e = 0; e < 4; ++e) r[e] = a[e] * sigm(a[e]) * b[e];
                    u32x2v w; w.x = cvt_pk_bf16(r[0], r[1]); w.y = cvt_pk_bf16(r[2], r[3]); *(u32x2v*)(rowp + bj * 64) = w; } }
    }
};

template <class Epi, class Sched, bool ALIGN_EPI = false, bool SP2 = false>
__device__ __forceinline__ void gemm_phase(PG8_LAS unsigned char* lds, const Gemm g, const Sched& S, const Epi& E, const int wid) {
    int lane; asm volatile("v_mbcnt_lo_u32_b32 %0, -1, 0\n\tv_mbcnt_hi_u32_b32 %0, -1, %0" : "=v"(lane)); const int tid = wid * 64 + lane, wr = wid >> 2, wc = wid & 3, fr = lane & 15, fq = lane >> 4;
    const int K = g.K, nt = K / BK;
    unsigned voffA[2], voffB[2];
#pragma unroll
    for (int i = 0; i < 2; ++i) { int R, C; stage_rc(tid * 16 + i * 8192, R, C); const int Rb = Epi::PERM ? ((R & ~31) + perm32(R & 31)) : R;
        voffA[i] = (unsigned)(R * K + C) * 2u; voffB[i] = (unsigned)(Rb * K + C) * 2u; }
    const size_t kstep = (size_t)(BK * 2);
    const size_t hstep = (size_t)HALF * K * 2;
    const size_t tstep = 2 * hstep;
    const unsigned ldsw = (unsigned)wid * 1024u;
    const int aoff = lds_byte(wr * 64 + fr, fq * 8), boff = lds_byte(wc * 32 + fr, fq * 8);
#define PG8_SA(b, h) (((b) * 2 + (h)) * HTB)
#define PG8_SB(b, h) ((4 + (b) * 2 + (h)) * HTB)
#define PG8_STAGE(bufoff, gbase, voff) do { _Pragma("unroll") for (int _i = 0; _i < 2; ++_i) \
        __builtin_amdgcn_global_load_lds((const unsigned*)((const char*)(gbase) + (voff)[_i]), (PG8_LAS unsigned*)(lds + (bufoff) + ldsw + _i * 8192), 16, 0, 0); } while (0)
#define PG8_LDA(dst, b, h) do { _Pragma("unroll") for (int m = 0; m < 4; ++m) _Pragma("unroll") for (int k = 0; k < 2; ++k) dst[m][k] = *(const PG8_LAS bf16x8*)(lds + PG8_SA(b, h) + aoff + m * 2048 + k * 1024); } while (0)
#define PG8_LDB(dst, b, h) do { _Pragma("unroll") for (int n = 0; n < 2; ++n) _Pragma("unroll") for (int k = 0; k < 2; ++k) dst[n][k] = *(const PG8_LAS bf16x8*)(lds + PG8_SB(b, h) + boff + n * 2048 + k * 1024); } while (0)
#define PG8_MMA(ai, bj, At, Bt) do { __builtin_amdgcn_s_setprio(1); _Pragma("unroll") for (int m = 0; m < 4; ++m) _Pragma("unroll") for (int n = 0; n < 2; ++n) _Pragma("unroll") for (int k = 0; k < 2; ++k) \
        acc[ai][bj][m][n] = __builtin_amdgcn_mfma_f32_16x16x32_bf16(Bt[n][k], At[m][k], acc[ai][bj][m][n], 0, 0, 0); __builtin_amdgcn_s_setprio(0); } while (0)
#define PG8_WAIT_V(n) asm volatile("s_waitcnt vmcnt(" #n ")" ::: "memory")
#define PG8_WAIT_L(n) asm volatile("s_waitcnt lgkmcnt(" #n ")" ::: "memory")
#define PG8_BAR __builtin_amdgcn_s_barrier()
#define PG8_SCHED __builtin_amdgcn_sched_barrier(0)
    Unit cur, nxt; int ui = 0;
    if (!S.next(0, cur)) return;
    f32x4 acc[2][2][4][2];
#pragma unroll
    for (int a = 0; a < 2; ++a)
#pragma unroll
        for (int b = 0; b < 2; ++b)
#pragma unroll
            for (int m = 0; m < 4; ++m)
#pragma unroll
                for (int n = 0; n < 2; ++n) acc[a][b][m][n] = (f32x4){0.f, 0.f, 0.f, 0.f};
    bf16x8 At[4][2], B0[2][2], B1[2][2];
    const char* cA = (const char*)g.A + (size_t)cur.pm * tstep; const char* cB = (const char*)g.Bt + (size_t)cur.pn * tstep;
    S.a_ready(cur);
    if constexpr (SP2) {
        PG8_STAGE(PG8_SB(0, 0), cB, voffB); PG8_STAGE(PG8_SB(0, 1), cB + hstep, voffB); PG8_STAGE(PG8_SA(0, 0), cA, voffA); PG8_STAGE(PG8_SA(0, 1), cA + hstep, voffA);
        if (wr == 1) PG8_BAR;
        PG8_WAIT_V(2); PG8_BAR;
        PG8_STAGE(PG8_SB(1, 0), cB + kstep, voffB); PG8_STAGE(PG8_SA(1, 0), cA + kstep, voffA); PG8_STAGE(PG8_SB(1, 1), cB + hstep + kstep, voffB);
        PG8_WAIT_V(6); PG8_BAR;
    } else {
        PG8_STAGE(PG8_SB(0, 0), cB, voffB); PG8_STAGE(PG8_SA(0, 0), cA, voffA); PG8_STAGE(PG8_SB(0, 1), cB + hstep, voffB); PG8_STAGE(PG8_SA(0, 1), cA + hstep, voffA);
        if (wr == 1) PG8_BAR;
        PG8_WAIT_V(4); PG8_BAR;
        PG8_STAGE(PG8_SB(1, 0), cB + kstep, voffB); PG8_STAGE(PG8_SA(1, 0), cA + kstep, voffA); PG8_STAGE(PG8_SB(1, 1), cB + hstep + kstep, voffB);
        PG8_WAIT_V(6); PG8_BAR;
    }
    for (;;) {
        const bool has_next = S.next(ui + 1, nxt);
        const char* nA = has_next ? (const char*)g.A + (size_t)nxt.pm * tstep : cA; const char* nB = has_next ? (const char*)g.Bt + (size_t)nxt.pn * tstep : cB;
        for (int t = 0; t < nt; t += 2) {
            const bool last = (t == nt - 2);
            const char* a1 = cA + (size_t)(t + 1) * kstep;
            const char* a2 = last ? nA : cA + (size_t)(t + 2) * kstep; const char* b2 = last ? nB : cB + (size_t)(t + 2) * kstep;
            const char* a3 = a2 + kstep; const char* b3 = b2 + kstep;
            if (last && has_next) S.a_ready(nxt);
            if constexpr (SP2) {
            PG8_LDB(B0, 0, 0); PG8_LDB(B1, 0, 1); PG8_SCHED; PG8_LDA(At, 0, 0); PG8_STAGE(PG8_SA(1, 1), a1 + hstep, voffA);
            PG8_WAIT_V(8); PG8_WAIT_L(0); PG8_BAR; PG8_MMA(0, 0, At, B0); PG8_MMA(0, 1, At, B1); PG8_BAR; PG8_SCHED;
            PG8_LDA(At, 0, 1); PG8_STAGE(PG8_SB(0, 0), b2, voffB); PG8_STAGE(PG8_SB(0, 1), b2 + hstep, voffB); PG8_STAGE(PG8_SA(0, 0), a2, voffA);
            PG8_WAIT_V(8); PG8_WAIT_L(0); PG8_BAR; PG8_MMA(1, 0, At, B0); PG8_MMA(1, 1, At, B1); PG8_BAR; PG8_SCHED;
            PG8_LDB(B0, 1, 0); PG8_LDB(B1, 1, 1); PG8_SCHED; PG8_LDA(At, 1, 0); PG8_STAGE(PG8_SA(0, 1), a2 + hstep, voffA);
            PG8_WAIT_V(8); PG8_WAIT_L(0); PG8_BAR; PG8_MMA(0, 0, At, B0); PG8_MMA(0, 1, At, B1); PG8_BAR; PG8_SCHED;
            PG8_LDA(At, 1, 1); PG8_STAGE(PG8_SB(1, 0), b3, voffB); PG8_STAGE(PG8_SB(1, 1), b3 + hstep, voffB); PG8_STAGE(PG8_SA(1, 0), a3, voffA);
            PG8_WAIT_V(8); PG8_WAIT_L(0); PG8_BAR; PG8_MMA(1, 0, At, B0); PG8_MMA(1, 1, At, B1); PG8_BAR; PG8_SCHED;
            } else {
            PG8_LDB(B0, 0, 0); PG8_SCHED; PG8_LDA(At, 0, 0); PG8_STAGE(PG8_SA(1, 1), a1 + hstep, voffA);
            PG8_WAIT_L(8); PG8_BAR; PG8_WAIT_L(0); PG8_MMA(0, 0, At, B0); PG8_BAR; PG8_SCHED;
            PG8_LDB(B1, 0, 1); PG8_STAGE(PG8_SB(0, 0), b2, voffB);
            PG8_BAR; PG8_WAIT_L(0); PG8_MMA(0, 1, At, B1); PG8_BAR;
            PG8_LDA(At, 0, 1); PG8_STAGE(PG8_SA(0, 0), a2, voffA);
            PG8_BAR; PG8_WAIT_L(0); PG8_MMA(1, 0, At, B0); PG8_BAR; PG8_SCHED;
            PG8_STAGE(PG8_SB(0, 1), b2 + hstep, voffB);
            PG8_WAIT_V(6); PG8_BAR; PG8_MMA(1, 1, At, B1); PG8_BAR;
            PG8_LDB(B0, 1, 0); PG8_SCHED; PG8_LDA(At, 1, 0); PG8_STAGE(PG8_SA(0, 1), a2 + hstep, voffA);
            PG8_WAIT_L(8); PG8_BAR; PG8_WAIT_L(0); PG8_MMA(0, 0, At, B0); PG8_BAR; PG8_SCHED;
            PG8_LDB(B1, 1, 1); PG8_STAGE(PG8_SB(1, 0), b3, voffB);
            PG8_BAR; PG8_WAIT_L(0); PG8_MMA(0, 1, At, B1); PG8_BAR;
            PG8_LDA(At, 1, 1); PG8_STAGE(PG8_SA(1, 0), a3, voffA);
            PG8_BAR; PG8_WAIT_L(0); PG8_MMA(1, 0, At, B0); PG8_BAR; PG8_SCHED;
            PG8_STAGE(PG8_SB(1, 1), b3 + hstep, voffB);
            PG8_WAIT_V(6); PG8_BAR; PG8_MMA(1, 1, At, B1); PG8_BAR;
            }
        }
        if constexpr (ALIGN_EPI) { if (wr == 0) PG8_BAR; }
        if constexpr (!Epi::AFTER_DRAIN) { asm volatile("s_nop 15\n\ts_nop 15" ::: "memory");   E(acc, cur, wr, wc, fr, fq); S.done(cur); }
        if (!has_next) break;
#pragma unroll
        for (int a = 0; a < 2; ++a)
#pragma unroll
            for (int b = 0; b < 2; ++b)
#pragma unroll
                for (int m = 0; m < 4; ++m)
#pragma unroll
                    for (int n = 0; n < 2; ++n) acc[a][b][m][n] = (f32x4){0.f, 0.f, 0.f, 0.f};
        cur = nxt; cA = nA; cB = nB; ++ui;
        if constexpr (ALIGN_EPI) { if (wr == 1) PG8_BAR; }
    }
    PG8_WAIT_V(0);
    if constexpr (!ALIGN_EPI) { if (wr == 0) PG8_BAR; }
    PG8_BAR;
    if constexpr (Epi::AFTER_DRAIN) { E.fused(acc, cur, wr, wc, fr, fq, lds, wid, lane); S.done(cur); }
#undef PG8_SA
#undef PG8_SB
#undef PG8_STAGE
#undef PG8_LDA
#undef PG8_LDB
#undef PG8_MMA
#undef PG8_WAIT_V
#undef PG8_WAIT_L
#undef PG8_BAR
#undef PG8_SCHED
}
}

#define PG8_SP2 true
#define PG8_ALIGN true
#define LAS __attribute__((address_space(3)))
typedef unsigned short bf16;
typedef short bf16x8 __attribute__((ext_vector_type(8)));
typedef short s16x4 __attribute__((ext_vector_type(4)));
typedef float f32x4 __attribute__((ext_vector_type(4)));
typedef float f32x16 __attribute__((ext_vector_type(16)));
typedef unsigned u32x4 __attribute__((ext_vector_type(4)));
typedef unsigned u32x2 __attribute__((ext_vector_type(2)));
using pg8::cvt_pk_bf16; using pg8::bf_lo; using pg8::bf_hi; using pg8::sigm;

constexpr int DM = 2048, NB = 4, SEQ = 8192, CTXL = 256, RB = SEQ + CTXL, MR = NB * RB, ML = NB * SEQ;
constexpr int NINP = 10240, DFF = 5632, NW = 8, NTHR = 512;
constexpr float RMS_EPS = 1e-6f;
constexpr float QSCALE = 0.07216878364870322f * 1.4426950408889634f;
constexpr size_t MiB = 1u << 20;
constexpr size_t WS_CTL = 0, WS_MOD = 1664 * 1024, WS_ROPEC = 2 * MiB, WS_ROPES = WS_ROPEC + MiB;
constexpr size_t WS_STAT = 64 * 1024, STAT_BYTES = 1536 * 1024, STAT_SQ = 917504;
static_assert(WS_STAT + STAT_BYTES <= WS_MOD && WS_MOD + 5 * 12288 * 4 <= WS_ROPEC, "control / statistics / modulation / rope map");
constexpr size_t WS_WUQ = 4 * MiB, WS_WUKV = 6 * MiB, WS_WBRA = 8 * MiB, WS_WBRH = 12 * MiB, WS_WOUT = 16 * MiB;
constexpr size_t WS_WIN = 24 * MiB, WS_CQ = 64 * MiB, WS_CKV = 97 * MiB, WS_KRR = WS_CKV + (size_t)MR * 256 * 2  , WS_ATTO = 24 * MiB;
constexpr size_t WS_KR = 118 * MiB;
constexpr size_t WS_H = 124 * MiB, WS_KN = 124 * MiB, WS_VV = 190 * MiB, WS_HGO = 124 * MiB, WS_ACT = 124 * MiB;
constexpr size_t WS_HGFF = 256 * MiB, WS_HGFB = 322 * MiB, WS_HGG = 388 * MiB, WS_HGQ = 454 * MiB, WS_HGI = 520 * MiB, WS_M1 = 124 * MiB, WS_T = 454 * MiB;
constexpr size_t WS_GATE = 586 * MiB, WS_OUTL = 586 * MiB, WS_H2 = 714 * MiB, WS_Y = 586 * MiB;
constexpr size_t WS_Q = 842 * MiB, WS_WFIN = 938 * MiB, WS_WFOUT = 982 * MiB, WS_END = 1004 * MiB;
static_assert(WS_KRR + (size_t)MR * 64 * 2 <= WS_KR && WS_KR + (size_t)MR * 64 * 2 <= WS_H && WS_CQ + (size_t)MR * 512 * 2 <= WS_CKV, "ws map 1");
static_assert(WS_H + (size_t)MR * DM * 2 <= WS_HGFF && WS_HGI + (size_t)MR * 1024 * 2 <= WS_GATE && WS_GATE + (size_t)ML * 4096 * 2 <= WS_Q && WS_Q + (size_t)ML * 1536 * 2 <= WS_WFIN, "ws map 2");
static_assert(WS_ACT + (size_t)ML * DFF * 2 <= WS_GATE && WS_WFIN + (size_t)2 * DFF * DM * 2 <= WS_WFOUT && WS_WFOUT + (size_t)DM * DFF * 2 <= WS_END, "ws map 3");
static_assert(WS_WIN + (size_t)NINP * DM * 2 <= WS_CQ && WS_ATTO + (size_t)ML * 1024 * 2 <= WS_CKV, "ws map 4");
constexpr int LDS_BYTES = 147456, LDS_MISC = 135168;

struct Args {
    const float *x, *c, *ctx, *c_ctx, *w_mod, *b_mod, *norm_g, *w_in, *q_norm, *kv_norm, *w_uq, *w_ukv, *hgrn_lb, *o_norm, *w_br_mla, *w_br_hgrn, *w_out, *w_ffn_in, *w_ffn_out;
    float* out; unsigned char* ws; int ph_lo, ph_hi;
};

__device__ __forceinline__ float wave_sum(float v) {
#pragma unroll
    for (int o = 1; o < 64; o <<= 1) v += __shfl_xor(v, o);
    return v;
}
#define LDS_WAIT() asm volatile("s_waitcnt lgkmcnt(0)" ::: "memory")
__device__ __forceinline__ int lane_now() { int l; asm volatile("v_mbcnt_lo_u32_b32 %0, -1, 0\n\tv_mbcnt_hi_u32_b32 %0, -1, %0" : "=v"(l)); return l; }

__device__ __forceinline__ int src_col(int mode, int n) {
    if (mode == 1) { if (n < 768) return n; if (n < 832) { const int j = n - 768; return 768 + (j >> 1) + 32 * (j & 1); } return n < 1024 ? -1 : n - 192; }
    if (mode == 2) { const int h = n / 192, c = n - h * 192; if (c < 128) return n; const int j = c - 128; return h * 192 + 128 + (j >> 1) + 32 * (j & 1); }
    if (mode == 3) { const int g = n >> 3, e = n & 7; return e < 4 ? 4 * g + e : DFF + 4 * g + (e - 4); }
    return n;
}
__device__ __forceinline__ void transpose_item(const float* W, int K, int Nsrc, int Ndst, bf16* WT, LAS float* scr, int item, int lane, int mode, float scale, const float* kscale = nullptr) {
    const int nblk = Ndst / 32, kb = item / nblk, nb = item - kb * nblk, k0 = 64 * kb, n0 = 32 * nb;
    const int sc = src_col(mode, n0 + (lane & 31));
#pragma unroll 8
    for (int i = 0; i < 32; ++i) { const int kk = 2 * i + (lane >> 5); scr[kk * 33 + (lane & 31)] = sc >= 0 ? W[(size_t)(k0 + kk) * Nsrc + sc] * (kscale ? scale * kscale[k0 + kk] : scale) : 0.f; }
    LDS_WAIT(); asm volatile("" ::: "memory");
    const int c = lane & 7;
#pragma unroll
    for (int j = 0; j < 4; ++j) { const int n = (lane >> 3) + 8 * j; const LAS float* s = scr + (8 * c) * 33 + n;
        u32x4 o; o.x = cvt_pk_bf16(s[0 * 33], s[1 * 33]); o.y = cvt_pk_bf16(s[2 * 33], s[3 * 33]); o.z = cvt_pk_bf16(s[4 * 33], s[5 * 33]); o.w = cvt_pk_bf16(s[6 * 33], s[7 * 33]);
        *(u32x4*)(WT + (size_t)(n0 + n) * K + k0 + 8 * c) = o; }
    LDS_WAIT(); asm volatile("" ::: "memory");
}
__device__ __forceinline__ void mod_gemv_item(const Args& a, LAS unsigned char* lds, int strip, int tid) {
    LAS float* S5 = (LAS float*)lds;
    LAS float* PART = (LAS float*)(lds + 40960);
    const int wave = tid >> 6, lane = tid & 63;
    for (int i = tid; i < 5 * DM; i += NTHR) { const int v = i / DM, k = i - v * DM; const float xv = v < 4 ? a.c[v * DM + k] : a.c_ctx[k]; S5[i] = xv * sigm(xv); }
    __syncthreads();
    const int kq = lane >> 4, c4 = lane & 15, cbase = strip * 64; const float* W = a.w_mod + cbase + 4 * c4;
    f32x4 acc[5];
#pragma unroll
    for (int v = 0; v < 5; ++v) acc[v] = (f32x4){0.f, 0.f, 0.f, 0.f};
    const int kb = wave * 256;
#pragma unroll 8
    for (int k = 0; k < 256; k += 4) { const int kk = kb + k + kq; const f32x4 w = *(const f32x4*)(W + (size_t)kk * (6 * DM));
#pragma unroll
        for (int v = 0; v < 5; ++v) acc[v] += w * S5[v * DM + kk]; }
#pragma unroll
    for (int v = 0; v < 5; ++v)
#pragma unroll
        for (int e = 0; e < 4; ++e) { float x = acc[v][e]; x += __shfl_xor(x, 16); x += __shfl_xor(x, 32); if (kq == 0) PART[(wave * 5 + v) * 64 + 4 * c4 + e] = x; }
    __syncthreads();
    if (tid < 320) { const int v = tid >> 6; float s = 0.f;
#pragma unroll
        for (int w = 0; w < 8; ++w) s += PART[(w * 5 + v) * 64 + lane];
        const int c0 = strip * 64 + lane; float* MOD = (float*)(a.ws + WS_MOD); MOD[v * (6 * DM) + c0] = s + a.b_mod[c0]; }
    __syncthreads();
}

__device__ __forceinline__ void p1_row(const Args& a, int R, int lane) {
    const int b = R / RB, r = R - b * RB; const float* src = r < CTXL ? a.ctx + ((size_t)b * CTXL + r) * DM : a.x + ((size_t)b * SEQ + (r - CTXL)) * DM;
    const float* MOD = (const float*)(a.ws + WS_MOD) + (r < CTXL ? 4 : b) * (6 * DM);
    f32x4 v[8]; float ss = 0.f;
#pragma unroll
    for (int j = 0; j < 8; ++j) { v[j] = *(const f32x4*)(src + 4 * (lane + 64 * j)); ss += (v[j][0] * v[j][0] + v[j][1] * v[j][1]) + (v[j][2] * v[j][2] + v[j][3] * v[j][3]); }
    const float rstd = rsqrtf(wave_sum(ss) * (1.f / DM) + RMS_EPS);
    bf16* H = (bf16*)(a.ws + WS_H) + (size_t)R * DM;
#pragma unroll
    for (int j = 0; j < 8; ++j) { const int c = 4 * (lane + 64 * j); const f32x4 g = *(const f32x4*)(a.norm_g + c), sh = *(const f32x4*)(MOD + c), sc = *(const f32x4*)(MOD + DM + c);
        f32x4 h;
#pragma unroll
        for (int e = 0; e < 4; ++e) h[e] = (v[j][e] * rstd * g[e]) * (1.f + sc[e]) + sh[e];
        u32x2 w; w.x = cvt_pk_bf16(h[0], h[1]); w.y = cvt_pk_bf16(h[2], h[3]); *(u32x2*)(H + c) = w; }
}
__device__ __forceinline__ void p3_row(const Args& a, int R, int lane) {
    const int b = R / RB, r = R - b * RB;
    { bf16* p = (bf16*)(a.ws + WS_CQ) + (size_t)R * 512 + 8 * lane; const u32x4 w = *(const u32x4*)p;
      float f[8] = {bf_lo(w.x), bf_hi(w.x), bf_lo(w.y), bf_hi(w.y), bf_lo(w.z), bf_hi(w.z), bf_lo(w.w), bf_hi(w.w)}; float ss = 0.f;
#pragma unroll
      for (int e = 0; e < 8; ++e) ss += f[e] * f[e];
      const float rstd = rsqrtf(wave_sum(ss) * (1.f / 512.f) + RMS_EPS); const float* g = a.q_norm + 8 * lane;
      u32x4 o; o.x = cvt_pk_bf16(f[0] * rstd * g[0], f[1] * rstd * g[1]); o.y = cvt_pk_bf16(f[2] * rstd * g[2], f[3] * rstd * g[3]); o.z = cvt_pk_bf16(f[4] * rstd * g[4], f[5] * rstd * g[5]); o.w = cvt_pk_bf16(f[6] * rstd * g[6], f[7] * rstd * g[7]);
      *(u32x4*)p = o; }
    { bf16* p = (bf16*)(a.ws + WS_CKV) + (size_t)R * 256 + 4 * lane; const u32x2 w = *(const u32x2*)p;
      float f[4] = {bf_lo(w.x), bf_hi(w.x), bf_lo(w.y), bf_hi(w.y)}; float ss = (f[0] * f[0] + f[1] * f[1]) + (f[2] * f[2] + f[3] * f[3]);
      const float rstd = rsqrtf(wave_sum(ss) * (1.f / 256.f) + RMS_EPS); const float* g = a.kv_norm + 4 * lane;
      u32x2 o; o.x = cvt_pk_bf16(f[0] * rstd * g[0], f[1] * rstd * g[1]); o.y = cvt_pk_bf16(f[2] * rstd * g[2], f[3] * rstd * g[3]);
      *(u32x2*)p = o; }
    if (lane < 32) { const bf16* p = (const bf16*)(a.ws + WS_KRR) + (size_t)R * 64; float x1 = __uint_as_float((unsigned)p[lane] << 16), x2 = __uint_as_float((unsigned)p[lane + 32] << 16);
      if (r >= CTXL) { const int t = r - CTXL; const float cs = ((const float*)(a.ws + WS_ROPEC))[t * 32 + lane], sn = ((const float*)(a.ws + WS_ROPES))[t * 32 + lane];
          const float y1 = x1 * cs - x2 * sn, y2 = x2 * cs + x1 * sn; x1 = y1; x2 = y2; }
      ((unsigned*)(a.ws + WS_KR))[(size_t)R * 32 + lane] = cvt_pk_bf16(x1, x2); }
}
__device__ __forceinline__ void p6_part(const Args& a, int m, int coff, int gidx) {
    const int b = m >> 13, R = b * RB + CTXL + (m & 8191);
    const size_t off = (size_t)R * 1024 + coff;
    const bf16* of = (const bf16*)(a.ws + WS_HGFF) + off; const bf16* ob = (const bf16*)(a.ws + WS_HGFB) + off; const bf16* hg = (const bf16*)(a.ws + WS_HGG) + off;
    float o[16]; float ss = 0.f;
#pragma unroll
    for (int q = 0; q < 2; ++q) { const u32x4 x = *(const u32x4*)(of + 8 * q), y = *(const u32x4*)(ob + 8 * q);
        o[8 * q + 0] = bf_lo(x.x) + bf_lo(y.x); o[8 * q + 1] = bf_hi(x.x) + bf_hi(y.x); o[8 * q + 2] = bf_lo(x.y) + bf_lo(y.y); o[8 * q + 3] = bf_hi(x.y) + bf_hi(y.y);
        o[8 * q + 4] = bf_lo(x.z) + bf_lo(y.z); o[8 * q + 5] = bf_hi(x.z) + bf_hi(y.z); o[8 * q + 6] = bf_lo(x.w) + bf_lo(y.w); o[8 * q + 7] = bf_hi(x.w) + bf_hi(y.w); }
#pragma unroll
    for (int e = 0; e < 16; ++e) ss += o[e] * o[e];
    ss += __shfl_xor(ss, 1); ss += __shfl_xor(ss, 2); ss += __shfl_xor(ss, 4);
    const float rstd = rsqrtf(ss * (1.f / 128.f) + RMS_EPS); const float* g = a.o_norm + 16 * gidx;
    bf16* dst = (bf16*)(a.ws + WS_HGFF) + off;
#pragma unroll
    for (int q = 0; q < 2; ++q) { const u32x4 gt = *(const u32x4*)(hg + 8 * q);
        const float s[8] = {bf_lo(gt.x), bf_hi(gt.x), bf_lo(gt.y), bf_hi(gt.y), bf_lo(gt.z), bf_hi(gt.z), bf_lo(gt.w), bf_hi(gt.w)}; float r[8];
#pragma unroll
        for (int e = 0; e < 8; ++e) r[e] = o[8 * q + e] * rstd * g[8 * q + e] * s[e];
        u32x4 w; w.x = cvt_pk_bf16(r[0], r[1]); w.y = cvt_pk_bf16(r[2], r[3]); w.z = cvt_pk_bf16(r[4], r[5]); w.w = cvt_pk_bf16(r[6], r[7]);
        *(u32x4*)(dst + 8 * q) = w; }
}
__device__ __forceinline__ void p9_row(const Args& a, int m, int lane) {
    const int b = m >> 13; const float* MOD = (const float*)(a.ws + WS_MOD) + b * (6 * DM);
    const bf16* ol = (const bf16*)(a.ws + WS_OUTL) + (size_t)m * DM; const float* xr = a.x + (size_t)m * DM; float* x1r = a.out + (size_t)m * DM; bf16* h2 = (bf16*)(a.ws + WS_H2) + (size_t)m * DM;
    float o[32]; float ss = 0.f;
#pragma unroll
    for (int j = 0; j < 4; ++j) { const u32x4 w = *(const u32x4*)(ol + 8 * lane + 512 * j);
        o[8 * j + 0] = bf_lo(w.x); o[8 * j + 1] = bf_hi(w.x); o[8 * j + 2] = bf_lo(w.y); o[8 * j + 3] = bf_hi(w.y); o[8 * j + 4] = bf_lo(w.z); o[8 * j + 5] = bf_hi(w.z); o[8 * j + 6] = bf_lo(w.w); o[8 * j + 7] = bf_hi(w.w); }
#pragma unroll
    for (int e = 0; e < 32; ++e) ss += o[e] * o[e];
    const float rstd1 = rsqrtf(wave_sum(ss) * (1.f / DM) + RMS_EPS);
    float ss2 = 0.f;
#pragma unroll
    for (int j = 0; j < 4; ++j) { const int c = 8 * lane + 512 * j;
#pragma unroll
        for (int q = 0; q < 2; ++q) { const f32x4 xv = *(const f32x4*)(xr + c + 4 * q), g = *(const f32x4*)(a.norm_g + DM + c + 4 * q), gt = *(const f32x4*)(MOD + 2 * DM + c + 4 * q);
#pragma unroll
            for (int e = 0; e < 4; ++e) { const float v = xv[e] + gt[e] * (o[8 * j + 4 * q + e] * rstd1 * g[e]); o[8 * j + 4 * q + e] = v; ss2 += v * v; }
            *(f32x4*)(x1r + c + 4 * q) = (f32x4){o[8 * j + 4 * q], o[8 * j + 4 * q + 1], o[8 * j + 4 * q + 2], o[8 * j + 4 * q + 3]}; } }
    const float rstd2 = rsqrtf(wave_sum(ss2) * (1.f / DM) + RMS_EPS);
#pragma unroll
    for (int j = 0; j < 4; ++j) { const int c = 8 * lane + 512 * j; float h[8];
#pragma unroll
        for (int q = 0; q < 2; ++q) { const f32x4 g = *(const f32x4*)(a.norm_g + 2 * DM + c + 4 * q), sh = *(const f32x4*)(MOD + 3 * DM + c + 4 * q), sc = *(const f32x4*)(MOD + 4 * DM + c + 4 * q);
#pragma unroll
            for (int e = 0; e < 4; ++e) h[4 * q + e] = (o[8 * j + 4 * q + e] * rstd2 * g[e]) * (1.f + sc[e]) + sh[e]; }
        u32x4 w; w.x = cvt_pk_bf16(h[0], h[1]); w.y = cvt_pk_bf16(h[2], h[3]); w.z = cvt_pk_bf16(h[4], h[5]); w.w = cvt_pk_bf16(h[6], h[7]);
        *(u32x4*)(h2 + c) = w; }
}
__device__ __forceinline__ void p12_row(const Args& a, int m, int lane) {
    const int b = m >> 13; const float* MOD = (const float*)(a.ws + WS_MOD) + b * (6 * DM);
    const bf16* yr = (const bf16*)(a.ws + WS_Y) + (size_t)m * DM; float* x1r = a.out + (size_t)m * DM;
    float o[32]; float ss = 0.f;
#pragma unroll
    for (int j = 0; j < 4; ++j) { const u32x4 w = *(const u32x4*)(yr + 8 * lane + 512 * j);
        o[8 * j + 0] = bf_lo(w.x); o[8 * j + 1] = bf_hi(w.x); o[8 * j + 2] = bf_lo(w.y); o[8 * j + 3] = bf_hi(w.y); o[8 * j + 4] = bf_lo(w.z); o[8 * j + 5] = bf_hi(w.z); o[8 * j + 6] = bf_lo(w.w); o[8 * j + 7] = bf_hi(w.w); }
#pragma unroll
    for (int e = 0; e < 32; ++e) ss += o[e] * o[e];
    const float rstd = rsqrtf(wave_sum(ss) * (1.f / DM) + RMS_EPS);
#pragma unroll
    for (int j = 0; j < 4; ++j) { const int c = 8 * lane + 512 * j;
#pragma unroll
        for (int q = 0; q < 2; ++q) { const f32x4 xv = *(const f32x4*)(x1r + c + 4 * q), g = *(const f32x4*)(a.norm_g + 3 * DM + c + 4 * q), gt = *(const f32x4*)(MOD + 5 * DM + c + 4 * q); f32x4 r;
#pragma unroll
            for (int e = 0; e < 4; ++e) r[e] = xv[e] + gt[e] * (o[8 * j + 4 * q + e] * rstd * g[e]);
            *(f32x4*)(x1r + c + 4 * q) = r; } }
}
namespace att {
constexpr int LDQ = 1536, LDK = 1024, LDO = 1024;
constexpr int SHM_V = 16384, SHM_K = 16384, SHM_KR = 8192, OFF_K = 32768, OFF_KR = 65536, OFF_WS = 81920, OFF_QR = 83968;
#define KSWZ(row, colB) ((row) * 256 + ((colB) ^ (((row) & 7) << 4)))
#define KRSWZ(row, colB) ((row) * 128 + ((colB) ^ ((((row) >> 1) & 7) << 4)))
#define SBAR() __builtin_amdgcn_sched_barrier(0)
#define ILV2() do { __builtin_amdgcn_sched_group_barrier(0x100, 8, 1); _Pragma("unroll") for (int g_ = 0; g_ < 12; ++g_) { __builtin_amdgcn_sched_group_barrier(0x008, 1, 1); __builtin_amdgcn_sched_group_barrier(0x100, 2, 1); __builtin_amdgcn_sched_group_barrier(0x002, 5, 1); } _Pragma("unroll") for (int g_ = 0; g_ < 4; ++g_) { __builtin_amdgcn_sched_group_barrier(0x008, 1, 1); __builtin_amdgcn_sched_group_barrier(0x002, 5, 1); } } while (0)
#define ILV1() do { __builtin_amdgcn_sched_group_barrier(0x100, 6, 0); _Pragma("unroll") for (int g_ = 0; g_ < 24; ++g_) { __builtin_amdgcn_sched_group_barrier(0x008, 1, 0); __builtin_amdgcn_sched_group_barrier(0x100, 1, 0); __builtin_amdgcn_sched_group_barrier(0x002, 5, 0); } } while (0)
__device__ __forceinline__ int crow(int r, int hi) { return (r & 3) + 8 * (r >> 2) + 4 * hi; }
__device__ __forceinline__ int v_st(int k, int c) { const int kk = (k & ~0xC) | ((k & 4) << 1) | ((k & 8) >> 1); return ((kk >> 3) * 4 + (c >> 5)) * 512 + ((kk & 7) * 32 + (c & 31)) * 2; }
__device__ __forceinline__ int v_rd_base(int lane) { return ((lane & 3) << 3) | (((lane >> 2) & 3) << 6) | (((lane >> 4) & 1) << 5) | (((lane >> 5) & 1) << 8); }
constexpr int v_rd_off(int d0, int ks, int half) { return d0 * 512 + ks * 4096 + half * 2048; }
template <int OFF> __device__ __forceinline__ s16x4 tr_read(int vb) { return __builtin_amdgcn_ds_read_tr16_b64_v4i16((LAS s16x4*)(unsigned)(vb + OFF)); }
template <int D0> __device__ __forceinline__ void pv_one(f32x16& od, int vb, bf16x8 pa0, bf16x8 pa1, bf16x8 pa2, bf16x8 pa3) {
  const s16x4 l0 = tr_read<v_rd_off(D0, 0, 0)>(vb), h0 = tr_read<v_rd_off(D0, 0, 1)>(vb), l1 = tr_read<v_rd_off(D0, 1, 0)>(vb), h1 = tr_read<v_rd_off(D0, 1, 1)>(vb);
  const s16x4 l2 = tr_read<v_rd_off(D0, 2, 0)>(vb), h2 = tr_read<v_rd_off(D0, 2, 1)>(vb), l3 = tr_read<v_rd_off(D0, 3, 0)>(vb), h3 = tr_read<v_rd_off(D0, 3, 1)>(vb);
#define PK(L, H) (bf16x8){L[0], L[1], L[2], L[3], H[0], H[1], H[2], H[3]}
  od = __builtin_amdgcn_mfma_f32_32x32x16_bf16(pa0, PK(l0, h0), od, 0, 0, 0);
  od = __builtin_amdgcn_mfma_f32_32x32x16_bf16(pa1, PK(l1, h1), od, 0, 0, 0);
  od = __builtin_amdgcn_mfma_f32_32x32x16_bf16(pa2, PK(l2, h2), od, 0, 0, 0);
  od = __builtin_amdgcn_mfma_f32_32x32x16_bf16(pa3, PK(l3, h3), od, 0, 0, 0);
#undef PK
}
__device__ __forceinline__ void qkt(f32x16& p0, f32x16& p1, const LAS unsigned char* Ks, const LAS unsigned char* KRs, const LAS unsigned char* QR_l, const bf16x8* qr, int r32, int hi, const float negm) {
#pragma unroll
  for (int r = 0; r < 16; ++r) { p0[r] = negm; p1[r] = negm; }
#pragma unroll
  for (int d0 = 0; d0 < 8; ++d0) { const int cb = (d0 * 16 + hi * 8) * 2;
    const bf16x8 b0 = *(const LAS bf16x8*)(Ks + KSWZ(r32, cb)); const bf16x8 b1 = *(const LAS bf16x8*)(Ks + KSWZ(32 + r32, cb));
    bf16x8 qf; if (d0 < 6) qf = qr[d0 < 6 ? d0 : 0]; else qf = *(const LAS bf16x8*)(QR_l + (d0 - 6) * 1024);
    p0 = __builtin_amdgcn_mfma_f32_32x32x16_bf16(b0, qf, p0, 0, 0, 0); p1 = __builtin_amdgcn_mfma_f32_32x32x16_bf16(b1, qf, p1, 0, 0, 0); }
#pragma unroll
  for (int d0 = 0; d0 < 4; ++d0) { const int cb = (d0 * 16 + hi * 8) * 2;
    const bf16x8 b0 = *(const LAS bf16x8*)(KRs + KRSWZ(r32, cb)); const bf16x8 b1 = *(const LAS bf16x8*)(KRs + KRSWZ(32 + r32, cb));
    const bf16x8 qf = *(const LAS bf16x8*)(QR_l + (2 + d0) * 1024);
    p0 = __builtin_amdgcn_mfma_f32_32x32x16_bf16(b0, qf, p0, 0, 0, 0); p1 = __builtin_amdgcn_mfma_f32_32x32x16_bf16(b1, qf, p1, 0, 0, 0); }
}
__device__ __forceinline__ void partialSM(f32x16& p0, f32x16& p1, float& m_reg, float& alpha, const float m_issue, const bool first = false) {
  float pmax = p0[0];
#pragma unroll
  for (int r = 1; r < 16; ++r) pmax = fmaxf(pmax, p0[r]);
#pragma unroll
  for (int r = 0; r < 16; ++r) pmax = fmaxf(pmax, p1[r]);
  { auto rr = __builtin_amdgcn_permlane32_swap(__float_as_uint(pmax), __float_as_uint(pmax), false, false); pmax = fmaxf(__uint_as_float(rr[0]), __uint_as_float(rr[1])); }
  if (first) { alpha = 1.f; m_reg = pmax + m_issue;
#pragma unroll
    for (int r = 0; r < 16; ++r) { p0[r] = p0[r] - pmax; p1[r] = p1[r] - pmax; }
    return; }
  const float delta = m_reg - m_issue;
  if (__builtin_expect(__all(pmax - delta <= 8.f) && __all(delta == 0.f), 1)) alpha = 1.f;
  else { const float smax = pmax + m_issue; const float mn = (smax - m_reg <= 8.f) ? m_reg : fmaxf(m_reg, smax); alpha = __builtin_amdgcn_exp2f(m_reg - mn); m_reg = mn; const float sh = mn - m_issue;
#pragma unroll
    for (int r = 0; r < 16; ++r) { p0[r] = p0[r] - sh; p1[r] = p1[r] - sh; } }
}
__device__ __forceinline__ void finishSM(f32x16& p0, f32x16& p1, float alpha, float& l_reg, bf16x8& pa0, bf16x8& pa1, bf16x8& pa2, bf16x8& pa3) {
#pragma unroll
  for (int r = 0; r < 16; ++r) { p0[r] = __builtin_amdgcn_exp2f(p0[r]); p1[r] = __builtin_amdgcn_exp2f(p1[r]); }
  float ps = 0.f;
#pragma unroll
  for (int r = 0; r < 16; ++r) ps += p0[r];
#pragma unroll
  for (int r = 0; r < 16; ++r) ps += p1[r];
  { auto rr = __builtin_amdgcn_permlane32_swap(__float_as_uint(ps), __float_as_uint(ps), false, false); ps = __uint_as_float(rr[0]) + __uint_as_float(rr[1]); }
  l_reg = l_reg * alpha + ps;
#define PK4(P, BASE, OUT) do { unsigned a0 = pg8::cvt_pk_bf16_safe(P[BASE + 0], P[BASE + 1]), a1 = pg8::cvt_pk_bf16_safe(P[BASE + 2], P[BASE + 3]);   \
    unsigned b0 = pg8::cvt_pk_bf16_safe(P[BASE + 4], P[BASE + 5]), b1 = pg8::cvt_pk_bf16_safe(P[BASE + 6], P[BASE + 7]);                              \
    auto r0 = __builtin_amdgcn_permlane32_swap(a0, b0, false, false); auto r1 = __builtin_amdgcn_permlane32_swap(a1, b1, false, false); \
    u32x4 w = {r0[0], r1[0], r0[1], r1[1]}; OUT = *reinterpret_cast<bf16x8*>(&w); } while (0)
  PK4(p0, 0, pa0); PK4(p0, 8, pa1); PK4(p1, 0, pa2); PK4(p1, 8, pa3);
#undef PK4
}
__device__ __forceinline__ void pv_d0(f32x16* o, int vb, bf16x8 pa0, bf16x8 pa1, bf16x8 pa2, bf16x8 pa3) {
  pv_one<0>(o[0], vb, pa0, pa1, pa2, pa3); pv_one<1>(o[1], vb, pa0, pa1, pa2, pa3); pv_one<2>(o[2], vb, pa0, pa1, pa2, pa3); pv_one<3>(o[3], vb, pa0, pa1, pa2, pa3);
}
__device__ __forceinline__ void attn_unit(const bf16* __restrict__ Qb, const bf16* __restrict__ Kh, const bf16* __restrict__ KRb, const bf16* __restrict__ Vh, bf16* __restrict__ Ob, int seq, LAS unsigned char* lds, const int wid) {
  const int lane = lane_now(), tid = wid * 64 + lane, r32 = lane & 31, hi = lane >> 5;
  LAS unsigned char* V_lds = lds; LAS unsigned char* K_lds = lds + OFF_K; LAS unsigned char* KR_lds = lds + OFF_KR;
  LAS float* wsf = (LAS float*)(lds + OFF_WS) + wid * 64; LAS float* li_l = wsf; LAS float* al_l = wsf + 32;
  float m_reg = -1e30f, l_reg = 0.f; f32x16 o[4];
#pragma unroll
  for (int d = 0; d < 4; ++d)
#pragma unroll
    for (int r = 0; r < 16; ++r) o[d][r] = 0.f;
  bf16x8 qr[6];
  const bf16* Qw = Qb + (size_t)(wid * 32 + r32) * LDQ + hi * 8;
#pragma unroll
  for (int d0 = 0; d0 < 6; ++d0) qr[d0] = *(const bf16x8*)(Qw + d0 * 16);
  LAS unsigned char* QR_l = lds + OFF_QR + (wid * 384 + lane) * 16;
#pragma unroll
  for (int d0 = 0; d0 < 6; ++d0) *(LAS bf16x8*)(QR_l + d0 * 1024) = *(const bf16x8*)(Qw + (6 + d0) * 16);
  const int sr = tid >> 4, sc = (tid & 15) * 8, vst0 = v_st(sr, sc), vst1 = v_st(32 + sr, sc);
  const int krr = tid >> 3, krc = (tid & 7) * 8;
  const int vb0 = (int)(unsigned)(uintptr_t)V_lds + v_rd_base(lane);
  bf16x8 sv0, sv1, sk0, sk1, skr;
#define SLOAD(k0) do { sv0 = *(const bf16x8*)(Vh + (size_t)((k0) + sr) * LDK + sc); sv1 = *(const bf16x8*)(Vh + (size_t)((k0) + 32 + sr) * LDK + sc); \
    sk0 = *(const bf16x8*)(Kh + (size_t)((k0) + sr) * LDK + sc); sk1 = *(const bf16x8*)(Kh + (size_t)((k0) + 32 + sr) * LDK + sc); \
    skr = *(const bf16x8*)(KRb + (size_t)((k0) + krr) * 64 + krc); } while (0)
#define SWRITE_V(b) do { *(LAS bf16x8*)(V_lds + (b) * SHM_V + vst0) = sv0; *(LAS bf16x8*)(V_lds + (b) * SHM_V + vst1) = sv1; } while (0)
#define SWRITE_K(b) do { *(LAS bf16x8*)(K_lds + (b) * SHM_K + KSWZ(sr, sc * 2)) = sk0; *(LAS bf16x8*)(K_lds + (b) * SHM_K + KSWZ(32 + sr, sc * 2)) = sk1; \
    *(LAS bf16x8*)(KR_lds + (b) * SHM_KR + KRSWZ(krr, krc * 2)) = skr; } while (0)
#define RESC(a) do { if (__any((a) < 1.f)) { if (hi == 0) al_l[r32] = (a); LDS_WAIT(); \
    _Pragma("unroll") for (int r = 0; r < 16; ++r) { const float al = al_l[crow(r, hi)]; _Pragma("unroll") for (int d = 0; d < 4; ++d) o[d][r] *= al; } } } while (0)
  f32x16 pA0, pA1, pB0, pB1; float alA, alB; bf16x8 pa0, pa1, pa2, pa3; const int NT = seq / 64;
  SLOAD(0); SWRITE_K(0); SWRITE_V(0); __syncthreads();
  qkt(pA0, pA1, K_lds, KR_lds, QR_l, qr, r32, hi, 0.f); partialSM(pA0, pA1, m_reg, alA, 0.f, true);
  SLOAD(64); SWRITE_K(1); SWRITE_V(1); __syncthreads();
  for (int j = 1; j + 1 < NT; j += 2) {
    SBAR(); const float mB_ = m_reg; qkt(pB0, pB1, K_lds + SHM_K, KR_lds + SHM_KR, QR_l, qr, r32, hi, -mB_);
    finishSM(pA0, pA1, alA, l_reg, pa0, pa1, pa2, pa3); ILV1(); SBAR();
    SLOAD((j + 1) * 64); SBAR();
    pv_d0(o, vb0, pa0, pa1, pa2, pa3); partialSM(pB0, pB1, m_reg, alB, mB_); ILV2(); SBAR();
    SWRITE_K(0); RESC(alB); __syncthreads(); SWRITE_V(0); SBAR();
    const float mA_ = m_reg; qkt(pA0, pA1, K_lds, KR_lds, QR_l, qr, r32, hi, -mA_);
    finishSM(pB0, pB1, alB, l_reg, pa0, pa1, pa2, pa3); ILV1(); SBAR();
    SLOAD((j + 2) * 64); SBAR();
    pv_d0(o, vb0 + SHM_V, pa0, pa1, pa2, pa3); partialSM(pA0, pA1, m_reg, alA, mA_); ILV2(); SBAR();
    SWRITE_K(1); RESC(alA); __syncthreads(); SWRITE_V(1); SBAR();
  }
  SBAR(); const float mT_ = m_reg; qkt(pB0, pB1, K_lds + SHM_K, KR_lds + SHM_KR, QR_l, qr, r32, hi, -mT_);
  finishSM(pA0, pA1, alA, l_reg, pa0, pa1, pa2, pa3); SBAR();
  pv_d0(o, vb0, pa0, pa1, pa2, pa3); partialSM(pB0, pB1, m_reg, alB, mT_);
  __syncthreads(); RESC(alB);
  finishSM(pB0, pB1, alB, l_reg, pa0, pa1, pa2, pa3); SBAR();
  pv_d0(o, vb0 + SHM_V, pa0, pa1, pa2, pa3);
  if (hi == 0) li_l[r32] = l_reg; LDS_WAIT();
  bf16* Ow = Ob + (size_t)(wid * 32) * LDO;
#pragma unroll
  for (int r = 0; r < 16; ++r) { const int orow = crow(r, hi); const float rl = __builtin_amdgcn_rcpf(li_l[orow]);
#pragma unroll
    for (int d0 = 0; d0 < 4; ++d0) Ow[(size_t)orow * LDO + d0 * 32 + r32] = (bf16)(pg8::cvt_pk_bf16_safe(o[d0][r] * rl, 0.f) & 0xffffu); }
  __syncthreads();
#undef SLOAD
#undef SWRITE_K
#undef SWRITE_V
#undef RESC
}
}
namespace hg {
constexpr int QD_OFF = 0, KD_OFF = 17408, KTT_OFF = 34816, HVT_OFF = 53248, SC_OFF = 71680, SEG_OFF = 80896, DEC_OFF = 84992;
__device__ __forceinline__ void scan_unit(const Args& a, int unit, LAS unsigned char* lds, const int wave) {
  const int b = unit >> 4, h = (unit >> 1) & 7, dir = unit & 1;
  const int lane = lane_now(), l15 = lane & 15, quad = lane >> 4;
  const bf16* HQ = (const bf16*)(a.ws + WS_HGQ) + h * 128; const bf16* HF = (const bf16*)(a.ws + (dir ? WS_HGFB : WS_HGFF)) + h * 128; const bf16* HV = (const bf16*)(a.ws + WS_HGI) + h * 128;
  bf16* HO = (bf16*)(a.ws + (dir ? WS_HGFB : WS_HGFF)) + h * 128;
  float lbv[2], oml[2];
#pragma unroll
  for (int e = 0; e < 2; ++e) { const int idx = dir * 1024 + h * 128 + 2 * lane + e; const float a0 = a.hgrn_lb[idx], a1 = a.hgrn_lb[2048 + idx]; lbv[e] = 1.f / (1.f + __expf(a1 - a0)); oml[e] = 1.f - lbv[e]; }
  f32x4 S[8];
#pragma unroll
  for (int d = 0; d < 8; ++d) S[d] = (f32x4){0.f, 0.f, 0.f, 0.f};
  unsigned xq[8], xf[8], xv[8];
#define CHUNK_OF(n) (dir ? ((n) < 4 ? 3 - (n) : 135 - (n)) : (n))
#define ROW_OF(c, i) ((size_t)b * RB + 64 * (c) + (dir ? 63 - (i) : (i)))
#define HLOAD(c) do { _Pragma("unroll") for (int r = 0; r < 8; ++r) { const size_t off = ROW_OF(c, 8 * wave + r) * 1024 + 2 * lane; \
      xq[r] = *(const unsigned*)(HQ + off); xf[r] = *(const unsigned*)(HF + off); xv[r] = *(const unsigned*)(HV + off); } } while (0)
  HLOAD(CHUNK_OF(0));
  for (int n = 0; n < 132; ++n) {
    const int c = CHUNK_OF(n); const bool lat = c >= 4;
    float cs[8][2], kk[8][2], qv[8][2]; unsigned hvr[8];
    { float run0 = 0.f, run1 = 0.f;
#pragma unroll
      for (int r = 0; r < 8; ++r) { const float f0 = lbv[0] + oml[0] * sigm(bf_lo(xf[r])), f1 = lbv[1] + oml[1] * sigm(bf_hi(xf[r]));
        run0 += __logf(f0); run1 += __logf(f1); cs[r][0] = run0; cs[r][1] = run1; kk[r][0] = 1.f - f0; kk[r][1] = 1.f - f1;
        qv[r][0] = bf_lo(xq[r]); qv[r][1] = bf_hi(xq[r]); hvr[r] = xv[r]; }
      *(LAS float*)(lds + SEG_OFF + (wave * 128 + 2 * lane) * 4) = run0; *(LAS float*)(lds + SEG_OFF + (wave * 128 + 2 * lane + 1) * 4) = run1; }
    if (n + 1 < 132) HLOAD(CHUNK_OF(n + 1));
    __syncthreads();
    { float pre0 = 0.f, pre1 = 0.f, tot0 = 0.f, tot1 = 0.f;
#pragma unroll
      for (int s = 0; s < 8; ++s) { const float v0 = *(LAS float*)(lds + SEG_OFF + (s * 128 + 2 * lane) * 4), v1 = *(LAS float*)(lds + SEG_OFF + (s * 128 + 2 * lane + 1) * 4);
        tot0 += v0; tot1 += v1; if (s < wave) { pre0 += v0; pre1 += v1; } }
      const float et0 = __expf(tot0), et1 = __expf(tot1);
      unsigned ktp0[4], ktp1[4], hv0[4], hv1[4];
#pragma unroll
      for (int r = 0; r < 8; r += 2) {
        float qd[2][2], kd[2][2], kt[2][2];
#pragma unroll
        for (int rr = 0; rr < 2; ++rr) { const float b0 = cs[r + rr][0] + pre0, b1 = cs[r + rr][1] + pre1;
          qd[rr][0] = qv[r + rr][0] * __expf(b0); qd[rr][1] = qv[r + rr][1] * __expf(b1);
          kd[rr][0] = kk[r + rr][0] * __expf(-b0); kd[rr][1] = kk[r + rr][1] * __expf(-b1);
          kt[rr][0] = kd[rr][0] * et0; kt[rr][1] = kd[rr][1] * et1;
          const int i = 8 * wave + r + rr;
          *(LAS unsigned*)(lds + QD_OFF + i * 272 + lane * 4) = pg8::cvt_pk_bf16_safe(qd[rr][0], qd[rr][1]);
          *(LAS unsigned*)(lds + KD_OFF + i * 272 + lane * 4) = pg8::cvt_pk_bf16_safe(kd[rr][0], kd[rr][1]); }
        ktp0[r >> 1] = pg8::cvt_pk_bf16_safe(kt[0][0], kt[1][0]); ktp1[r >> 1] = pg8::cvt_pk_bf16_safe(kt[0][1], kt[1][1]);
        hv0[r >> 1] = (hvr[r] & 0xffffu) | (hvr[r + 1] << 16); hv1[r >> 1] = (hvr[r] >> 16) | (hvr[r + 1] & 0xffff0000u); }
      *(LAS u32x4*)(lds + KTT_OFF + (2 * lane) * 144 + wave * 16) = (u32x4){ktp0[0], ktp0[1], ktp0[2], ktp0[3]};
      *(LAS u32x4*)(lds + KTT_OFF + (2 * lane + 1) * 144 + wave * 16) = (u32x4){ktp1[0], ktp1[1], ktp1[2], ktp1[3]};
      *(LAS u32x4*)(lds + HVT_OFF + (2 * lane) * 144 + wave * 16) = (u32x4){hv0[0], hv0[1], hv0[2], hv0[3]};
      *(LAS u32x4*)(lds + HVT_OFF + (2 * lane + 1) * 144 + wave * 16) = (u32x4){hv1[0], hv1[1], hv1[2], hv1[3]};
      if (wave == 0) { *(LAS float*)(lds + DEC_OFF + (2 * lane) * 4) = et0; *(LAS float*)(lds + DEC_OFF + (2 * lane + 1) * 4) = et1; } }
    __syncthreads();
    if (lat) {
#pragma unroll
      for (int e = 0; e < 2; ++e) { const int id = 2 * wave + e, it = id >> 2, st = id & 3; f32x4 acc = (f32x4){0.f, 0.f, 0.f, 0.f};
#pragma unroll
        for (int ks = 0; ks < 4; ++ks) { const bf16x8 av = *(const LAS bf16x8*)(lds + QD_OFF + (it * 16 + l15) * 272 + (ks * 32 + quad * 8) * 2);
          const bf16x8 bv = *(const LAS bf16x8*)(lds + KD_OFF + (st * 16 + l15) * 272 + (ks * 32 + quad * 8) * 2);
          acc = __builtin_amdgcn_mfma_f32_16x16x32_bf16(av, bv, acc, 0, 0, 0); }
#pragma unroll
        for (int j = 0; j < 4; ++j) { const int i = it * 16 + quad * 4 + j, s = st * 16 + l15; const float v = s <= i ? acc[j] : 0.f;
          *(LAS unsigned short*)(lds + SC_OFF + i * 144 + s * 2) = (unsigned short)(pg8::cvt_pk_bf16_safe(v, 0.f) & 0xffffu); } }
    }
    __syncthreads();
    { const int vs = 16 * wave;
      bf16x8 hvf[2];
#pragma unroll
      for (int ks = 0; ks < 2; ++ks) hvf[ks] = *(const LAS bf16x8*)(lds + HVT_OFF + (vs + l15) * 144 + (ks * 32 + quad * 8) * 2);
      if (lat) {
        bf16x8 sf[4];
#pragma unroll
        for (int ks = 0; ks < 4; ++ks) { u32x4 w; w.x = pg8::cvt_pk_bf16_safe(S[2 * ks][0], S[2 * ks][1]); w.y = pg8::cvt_pk_bf16_safe(S[2 * ks][2], S[2 * ks][3]); w.z = pg8::cvt_pk_bf16_safe(S[2 * ks + 1][0], S[2 * ks + 1][1]); w.w = pg8::cvt_pk_bf16_safe(S[2 * ks + 1][2], S[2 * ks + 1][3]);
          sf[ks] = __builtin_bit_cast(bf16x8, w); }
#pragma unroll
        for (int it = 0; it < 4; ++it) { f32x4 acc = (f32x4){0.f, 0.f, 0.f, 0.f};
#pragma unroll
          for (int ks = 0; ks < 2; ++ks) { const bf16x8 av = *(const LAS bf16x8*)(lds + SC_OFF + (it * 16 + l15) * 144 + (ks * 32 + quad * 8) * 2);
            acc = __builtin_amdgcn_mfma_f32_16x16x32_bf16(av, hvf[ks], acc, 0, 0, 0); }
#pragma unroll
          for (int ks = 0; ks < 4; ++ks) { const u32x2 lo = *(const LAS u32x2*)(lds + QD_OFF + (it * 16 + l15) * 272 + (ks * 32 + quad * 4) * 2);
            const u32x2 hi2 = *(const LAS u32x2*)(lds + QD_OFF + (it * 16 + l15) * 272 + (ks * 32 + 16 + quad * 4) * 2);
            const u32x4 w = (u32x4){lo.x, lo.y, hi2.x, hi2.y};
            acc = __builtin_amdgcn_mfma_f32_16x16x32_bf16(__builtin_bit_cast(bf16x8, w), sf[ks], acc, 0, 0, 0); }
#pragma unroll
          for (int j = 0; j < 4; ++j) { const int i = it * 16 + quad * 4 + j;
            HO[ROW_OF(c, i) * 1024 + vs + l15] = (bf16)(pg8::cvt_pk_bf16_safe(acc[j], 0.f) & 0xffffu); } }
      }
#pragma unroll
      for (int dt = 0; dt < 8; ++dt) { const f32x4 dc = *(const LAS f32x4*)(lds + DEC_OFF + (16 * dt + 4 * quad) * 4);
        f32x4 sacc = S[dt] * dc;
#pragma unroll
        for (int ks = 0; ks < 2; ++ks) { const bf16x8 av = *(const LAS bf16x8*)(lds + KTT_OFF + (dt * 16 + l15) * 144 + (ks * 32 + quad * 8) * 2);
          sacc = __builtin_amdgcn_mfma_f32_16x16x32_bf16(av, hvf[ks], sacc, 0, 0, 0); }
        S[dt] = sacc; } }
  }
#undef HLOAD
#undef CHUNK_OF
#undef ROW_OF
}
}
#define XB_TMO      128
#define XB_XCNT(j)  (256  + 64 * (j))
#define XB_XSUB(j)  (1280 + 64 * (j))
#define XB_XGEN(j)  (2304 + 64 * (j))
#define XB_TOP      3328
#define XB_TOPGEN   3392
#define XCD_BAR_WORDS 3456
#define XB_SPIN_CAP (1u << 20)
__device__ __forceinline__ unsigned xb_ld(unsigned* p)              { return __hip_atomic_load(p, __ATOMIC_RELAXED, __HIP_MEMORY_SCOPE_AGENT); }
__device__ __forceinline__ unsigned xb_add(unsigned* p, unsigned v) { return __hip_atomic_fetch_add(p, v, __ATOMIC_RELAXED, __HIP_MEMORY_SCOPE_AGENT); }
__device__ __forceinline__ unsigned xb_xcc_id() { return (unsigned)__builtin_amdgcn_s_getreg((3 << 11) | 20) & 0xFu; }
#define XB_SPIN(cond, bar) do { unsigned _sp = 0; while (cond) { __builtin_amdgcn_s_sleep(1); \
    if ((++_sp & 255u) == 0u) { if (xb_ld(&(bar)[XB_TMO])) break; if (_sp > XB_SPIN_CAP) { atomicAdd(&(bar)[XB_TMO], 1u); break; } } } } while (0)
struct XcdBarrier { unsigned* bar; unsigned x; volatile LAS unsigned* st; };
__device__ __forceinline__ XcdBarrier xcd_barrier_post(unsigned* bar, volatile LAS unsigned* st, bool leader) {
    XcdBarrier b; b.bar = bar; b.x = xb_xcc_id(); b.st = st;
    if (leader) (void)xb_add(&bar[XB_XCNT(b.x)], 1u);
    return b;
}
__device__ __forceinline__ void xcd_barrier_complete(unsigned* bar, unsigned x, unsigned& nloc, unsigned& nx) {
    const unsigned G = gridDim.x * gridDim.y * gridDim.z;
    unsigned sum, cnt, mine, sp = 0u;
    for (;;) {
        sum = 0u; cnt = 0u; mine = 0u;
#pragma unroll
        for (unsigned j = 0; j < 16; ++j) { const unsigned c = xb_ld(&bar[XB_XCNT(j)]); sum += c; cnt += (c > 0u) ? 1u : 0u; mine = (j == x) ? c : mine; }
        if (sum == G) break;
        __builtin_amdgcn_s_sleep(1);
        if ((++sp & 255u) == 0u) { if (xb_ld(&bar[XB_TMO])) break; if (sp > XB_SPIN_CAP) { atomicAdd(&bar[XB_TMO], 1u); break; } }
    }
    nloc = mine > 0u ? mine : 1u; nx = cnt > 0u ? cnt : 1u;
}
__device__ __forceinline__ void xcd_barrier(const XcdBarrier& b, bool leader) {
    asm volatile("s_waitcnt vmcnt(0)" ::: "memory");
    __syncthreads();
    if (leader) {
        unsigned* bar = b.bar;
        __builtin_amdgcn_s_waitcnt(0);
        unsigned nloc = b.st[0], nx = b.st[1];
        if (nloc == 0u) { xcd_barrier_complete(bar, b.x, nloc, nx); b.st[0] = nloc; b.st[1] = nx; }
        const unsigned old = xb_add(&bar[XB_XSUB(b.x)], 1u);
        const unsigned gen = old / nloc;
        if (old + 1u == (gen + 1u) * nloc) {
            __builtin_amdgcn_fence(__ATOMIC_RELEASE, "agent");
            asm volatile("s_waitcnt vmcnt(0)" ::: "memory");
            const unsigned og = xb_add(&bar[XB_TOP], 1u);
            const unsigned tg = og / nx;
            if (og + 1u == (tg + 1u) * nx) xb_add(&bar[XB_TOPGEN], 1u);
            else XB_SPIN(xb_ld(&bar[XB_TOPGEN]) == tg, bar);
            __builtin_amdgcn_fence(__ATOMIC_ACQUIRE, "agent");
            xb_add(&bar[XB_XGEN(b.x)], 1u);
            asm volatile("s_waitcnt vmcnt(0)" ::: "memory");
        } else {
            XB_SPIN(xb_ld(&bar[XB_XGEN(b.x)]) == gen, bar);
            __builtin_amdgcn_fence(__ATOMIC_ACQUIRE, "agent");
            asm volatile("s_waitcnt vmcnt(0)" ::: "memory");
        }
    }
    __syncthreads();
}
__device__ __forceinline__ void ffn_transpose_drain(const Args& a, LAS unsigned char* lds, unsigned* ctr, const int wave) {
    constexpr int I_FI = (DM / 64) * (2 * DFF / 32), I_FO = (DFF / 64) * (DM / 32), NIT = I_FI + I_FO;
    LAS unsigned* slot = (LAS unsigned*)(lds + LDS_MISC);
    LAS float* scr = (LAS float*)(lds + wave * 16384);
    const int lane = lane_now();
    for (;;) {
        if (wave == 0 && lane == 0) slot[1] = __hip_atomic_fetch_add(ctr, 8u, __ATOMIC_RELAXED, __HIP_MEMORY_SCOPE_AGENT);
        __syncthreads();
        const int it = (int)slot[1] + wave;
        __syncthreads();
        if (it - wave >= NIT) break;
        if (it < I_FI) transpose_item(a.w_ffn_in, DM, 2 * DFF, 2 * DFF, (bf16*)(a.ws + WS_WFIN), scr, it, lane, 3, 1.f);
        else if (it < NIT) transpose_item(a.w_ffn_out, DFF, DM, DM, (bf16*)(a.ws + WS_WFOUT), scr, it - I_FI, lane, 0, 1.f);
    }
}
__global__ void __launch_bounds__(NTHR, 2) fwd_megakernel(Args a) {
    extern __shared__ __attribute__((aligned(16))) unsigned char lds_raw[];
    LAS unsigned char* lds = (LAS unsigned char*)lds_raw;
    cg::grid_group grid = cg::this_grid();
    const int wave = __builtin_amdgcn_readfirstlane((int)threadIdx.x >> 6);
    const int G = gridDim.x, bx = blockIdx.x;
    const int gw = bx * NW + wave, NGW = G * NW;
    unsigned* ctl = (unsigned*)(a.ws + WS_CTL);
    const int lo = a.ph_lo, hi = a.ph_hi;
#ifdef PROBE_HI
#define IN(k) ((k) < PROBE_HI)
#define SEAMON(k) ((k) < PROBE_HI)
#else
#define IN(k) (lo <= (k) && (k) < hi)
#define SEAMON(k) (IN(k) && IN((k) + 1))
#endif
    { volatile LAS unsigned* st0 = (volatile LAS unsigned*)(lds + LDS_MISC + 16); if (wave == 0 && lane_now() < 2) st0[lane_now()] = 0u; }
    __syncthreads();
    XcdBarrier xbar = xcd_barrier_post(ctl + 1024, (volatile LAS unsigned*)(lds + LDS_MISC + 16), wave == 0 && lane_now() == 0);
#define SEAM(k) do { if (SEAMON(k)) { xcd_barrier(xbar, wave == 0 && lane_now() == 0); if ((k) == 1) grid.sync(); } } while (0)

    if (IN(0)) {
        const int lane = lane_now(), tid = wave * 64 + lane;
        if (bx < 192) { mod_gemv_item(a, lds, bx, tid);
            asm volatile("s_waitcnt vmcnt(0)" ::: "memory"); __syncthreads();
            if (wave == 0 && lane == 0) { __builtin_amdgcn_fence(__ATOMIC_RELEASE, "agent"); asm volatile("s_waitcnt vmcnt(0)" ::: "memory"); (void)__hip_atomic_fetch_add(ctl + 7, 1u, __ATOMIC_RELAXED, __HIP_MEMORY_SCOPE_AGENT); } }
        LAS float* scr = (LAS float*)(lds + wave * 16384);
        constexpr int I_IN = (DM / 64) * (NINP / 32), I_UQ = (512 / 64) * (1536 / 32), I_UKV = (256 / 64) * (2048 / 32), I_BR = (1024 / 64) * (2048 / 32), I_OUT = (2048 / 64) * (2048 / 32);
        constexpr int NIT = I_IN + I_UQ + I_UKV + 2 * I_BR + I_OUT;
        for (int it = gw; it < NIT; it += NGW) { int r = it;
            if (r < I_IN) { transpose_item(a.w_in, DM, 10048, NINP, (bf16*)(a.ws + WS_WIN), scr, r, lane, 1, 1.f); continue; } r -= I_IN;
            if (r < I_UQ) { transpose_item(a.w_uq, 512, 1536, 1536, (bf16*)(a.ws + WS_WUQ), scr, r, lane, 2, QSCALE, a.q_norm); continue; } r -= I_UQ;
            if (r < I_UKV) { transpose_item(a.w_ukv, 256, 2048, 2048, (bf16*)(a.ws + WS_WUKV), scr, r, lane, 0, 1.f, a.kv_norm); continue; } r -= I_UKV;
            if (r < I_BR) { transpose_item(a.w_br_mla, 1024, 2048, 2048, (bf16*)(a.ws + WS_WBRA), scr, r, lane, 0, 1.f); continue; } r -= I_BR;
            if (r < I_BR) { transpose_item(a.w_br_hgrn, 1024, 2048, 2048, (bf16*)(a.ws + WS_WBRH), scr, r, lane, 0, 1.f); continue; } r -= I_BR;
            transpose_item(a.w_out, 2048, 2048, 2048, (bf16*)(a.ws + WS_WOUT), scr, r, lane, 0, 1.f); }
        float* RC = (float*)(a.ws + WS_ROPEC); float* RS = (float*)(a.ws + WS_ROPES);
        for (int i = bx * NTHR + tid; i < SEQ * 32; i += G * NTHR) { const int t = i >> 5, j = i & 31; const float pos = (float)(j < 16 ? (t >> 6) : (t & 63));
            const float inv = exp2f(-(float)(j & 15) * (13.287712379549449f / 16.f)); const float rev = pos * inv * 0.15915494309189535f;
            RC[i] = __builtin_amdgcn_cosf(rev); RS[i] = __builtin_amdgcn_sinf(rev); }
    }
    if (IN(1)) { const int lane = lane_now();
        if (wave == 0 && lane == 0) { unsigned sp = 0; while (__hip_atomic_load(ctl + 7, __ATOMIC_RELAXED, __HIP_MEMORY_SCOPE_AGENT) < 192u) { __builtin_amdgcn_s_sleep(2); if (++sp > (1u << 22)) break; }
            __builtin_amdgcn_fence(__ATOMIC_ACQUIRE, "agent"); asm volatile("s_waitcnt vmcnt(0)" ::: "memory"); }
        __syncthreads();
        for (int R = gw; R < MR; R += NGW) p1_row(a, R, lane); }
    SEAM(1);
    if (IN(2)) {
        pg8::Gemm g{(const bf16*)(a.ws + WS_H), (const bf16*)(a.ws + WS_WIN), MR, NINP, DM}; pg8::Order S; S.init(MR, NINP, G, bx, 0);
        pg8::EpiIn E{(bf16*)(a.ws + WS_CQ), (bf16*)(a.ws + WS_CKV), (bf16*)(a.ws + WS_KR), (bf16*)(a.ws + WS_HGQ), (bf16*)(a.ws + WS_HGFF), (bf16*)(a.ws + WS_HGFB), (bf16*)(a.ws + WS_HGI), (bf16*)(a.ws + WS_HGG), (bf16*)(a.ws + WS_GATE),
                     (unsigned long long*)(a.ws + WS_STAT + STAT_SQ), (unsigned long long*)(a.ws + WS_STAT + STAT_SQ) + MR, (const float*)(a.ws + WS_ROPEC), (const float*)(a.ws + WS_ROPES)};
        pg8::gemm_phase<pg8::EpiIn, pg8::Order, PG8_ALIGN, PG8_SP2>(lds, g, S, E, wave);
    }
    SEAM(2);
    if (IN(4)) {
        { pg8::Gemm g{(const bf16*)(a.ws + WS_CQ), (const bf16*)(a.ws + WS_WUQ), ML, 1536, 512}; pg8::Order S; S.init(ML, 1536, G, bx, 1);
          pg8::EpiQ E{(bf16*)(a.ws + WS_Q), (const float*)(a.ws + WS_ROPEC), (const float*)(a.ws + WS_ROPES), (const unsigned long long*)(a.ws + WS_STAT + STAT_SQ)};
          pg8::gemm_phase<pg8::EpiQ, pg8::Order, PG8_ALIGN, PG8_SP2>(lds, g, S, E, wave); }
        __syncthreads();
        { pg8::Gemm g{(const bf16*)(a.ws + WS_CKV), (const bf16*)(a.ws + WS_WUKV), MR, 2048, 256}; pg8::Order S; S.init(MR, 2048, G, bx, 0);
          pg8::EpiKV E{(bf16*)(a.ws + WS_KN), (bf16*)(a.ws + WS_VV), (const unsigned long long*)(a.ws + WS_STAT + STAT_SQ) + MR};
          pg8::gemm_phase<pg8::EpiKV, pg8::Order, PG8_ALIGN, PG8_SP2>(lds, g, S, E, wave); }
    }
    SEAM(4);
    if (IN(5)) {
        if (bx < 64) {
            hg::scan_unit(a, bx, lds, wave);
            asm volatile("s_waitcnt vmcnt(0)" ::: "memory"); __syncthreads();
            LAS unsigned* slot3 = (LAS unsigned*)(lds + LDS_MISC);
            if (wave == 0 && lane_now() == 0) { __builtin_amdgcn_fence(__ATOMIC_RELEASE, "agent"); asm volatile("s_waitcnt vmcnt(0)" ::: "memory");
                const unsigned old = __hip_atomic_fetch_add(ctl + 8 + (bx >> 1), 1u, __ATOMIC_RELAXED, __HIP_MEMORY_SCOPE_AGENT);
                __builtin_amdgcn_fence(__ATOMIC_ACQUIRE, "agent"); asm volatile("s_waitcnt vmcnt(0)" ::: "memory"); slot3[3] = old; }
            __syncthreads();
            if (slot3[3] == 1u) { const int lane = lane_now(), b = bx >> 4, h = (bx >> 1) & 7;
#pragma unroll 2
                for (int r0 = wave * 8; r0 < SEQ; r0 += 64) p6_part(a, b * SEQ + r0 + (lane >> 3), h * 128 + 16 * (lane & 7), lane & 7); }
        }
        __syncthreads();
        LAS unsigned* slot = (LAS unsigned*)(lds + LDS_MISC);
        for (;;) {
            if (wave == 0 && lane_now() == 0) slot[0] = __hip_atomic_fetch_add(ctl, 1u, __ATOMIC_RELAXED, __HIP_MEMORY_SCOPE_AGENT);
            __syncthreads();
            const unsigned u = slot[0];
            __syncthreads();
            if (u >= (unsigned)(NB * 8 * 32)) break;
            const int qb = u & 31, h = (u >> 5) & 7, b = u >> 8;
            const size_t R0 = (size_t)b * RB, m0 = (size_t)b * SEQ + qb * 256;
            att::attn_unit((const bf16*)(a.ws + WS_Q) + m0 * 1536 + h * 192, (const bf16*)(a.ws + WS_KN) + R0 * 1024 + h * 128, (const bf16*)(a.ws + WS_KR) + R0 * 64,
                           (const bf16*)(a.ws + WS_VV) + R0 * 1024 + h * 128, (bf16*)(a.ws + WS_ATTO) + m0 * 1024 + h * 128, RB, lds, wave);
        }
        __syncthreads();
        ffn_transpose_drain(a, lds, ctl + 2, wave);
    }
    SEAM(5);
    if (IN(6)) {
        ffn_transpose_drain(a, lds, ctl + 2, wave);
        __syncthreads();
        pg8::Gemm g{(const bf16*)(a.ws + WS_ATTO), (const bf16*)(a.ws + WS_WBRA), ML, DM, 1024}; pg8::Order S; S.init(ML, DM, G, bx, 0);
        pg8::EpiGate<false> E{(bf16*)(a.ws + WS_T), (const bf16*)(a.ws + WS_GATE), nullptr, 0, 0};
        pg8::gemm_phase<pg8::EpiGate<false>, pg8::Order, PG8_ALIGN, PG8_SP2>(lds, g, S, E, wave);
        asm volatile("s_waitcnt vmcnt(0)" ::: "memory"); __syncthreads();
    }
    if (IN(7)) {
        pg8::Gemm g{(const bf16*)(a.ws + WS_HGFF), (const bf16*)(a.ws + WS_WBRH), ML, DM, 1024}; pg8::Order S; S.init(ML, DM, G, bx, 1);
        pg8::EpiGate<true> E{(bf16*)(a.ws + WS_M1), (const bf16*)(a.ws + WS_GATE), (const bf16*)(a.ws + WS_T), 2048, 1};
        pg8::gemm_phase<pg8::EpiGate<true>, pg8::Order, PG8_ALIGN, PG8_SP2>(lds, g, S, E, wave);
    }
    SEAM(7);
    if (IN(8)) {
        unsigned long long* ST = (unsigned long long*)(a.ws + WS_STAT); unsigned* CN = (unsigned*)(a.ws + WS_STAT + 3 * 262144);
        pg8::Gemm g{(const bf16*)(a.ws + WS_M1), (const bf16*)(a.ws + WS_WOUT), ML, DM, DM}; pg8::OrderPanel S; S.init(G, bx);
        pg8::EpiRes1 E{a.x, a.out, (bf16*)(a.ws + WS_H2), (const float*)(a.ws + WS_MOD), a.norm_g, ST, ST + 32768, CN, CN + 128 * 64};
        pg8::gemm_phase<pg8::EpiRes1, pg8::OrderPanel, PG8_ALIGN, PG8_SP2>(lds, g, S, E, wave);
    }
    SEAM(8);
    if (IN(10)) {
        pg8::Gemm g{(const bf16*)(a.ws + WS_H2), (const bf16*)(a.ws + WS_WFIN), ML, 2 * DFF, DM}; pg8::Order S; S.init(ML, 2 * DFF, G, bx, 0);
        pg8::EpiSwiGLU E{(bf16*)(a.ws + WS_ACT)};
        pg8::gemm_phase<pg8::EpiSwiGLU, pg8::Order, PG8_ALIGN, PG8_SP2>(lds, g, S, E, wave);
    }
    SEAM(10);
    if (IN(11)) {
        unsigned long long* ST = (unsigned long long*)(a.ws + WS_STAT); unsigned* CN = (unsigned*)(a.ws + WS_STAT + 3 * 262144);
        pg8::Gemm g{(const bf16*)(a.ws + WS_ACT), (const bf16*)(a.ws + WS_WFOUT), ML, DM, DFF}; pg8::OrderPanel S; S.init(G, bx);
        pg8::EpiRes2 E{a.out, (const float*)(a.ws + WS_MOD), a.norm_g, ST + 2 * 32768, CN + 2 * 128 * 64};
        pg8::gemm_phase<pg8::EpiRes2, pg8::OrderPanel, PG8_ALIGN, PG8_SP2>(lds, g, S, E, wave);
    }
#ifdef PROBE_HI
    {
        const size_t offs[] = {PROBE_OFFS}; const size_t lens[] = {PROBE_LENS};
        constexpr int NBUF = sizeof(offs) / sizeof(offs[0]);
        for (size_t i = (size_t)bx * NTHR + wave * 64 + lane_now(); i < (size_t)ML * DM; i += (size_t)G * NTHR) { float acc = 0.f;
            for (int q = 0; q < NBUF; ++q) { const bf16* bp = (const bf16*)(a.ws + offs[q]); const float v = __uint_as_float((unsigned)bp[i % lens[q]] << 16); acc += (fabsf(v) < 1e30f) ? v : 1000.f; }
            a.out[i] = acc; }
    }
#endif
#undef IN
#undef SEAM
}

extern "C" void kernel_launch(void* const* d_in, const int* in_sizes, int n_in, void* d_out, int out_size, void* d_ws, size_t ws_size, hipStream_t stream) {
    static int grid = 0;
    if (grid == 0) {
        if (n_in != 19 || in_sizes[0] != ML * DM || out_size != ML * DM || ws_size < WS_END) { fprintf(stderr, "kernel_launch: shape/workspace mismatch (n_in %d, in0 %d, out %d, ws %zu < %zu)\n", n_in, n_in > 0 ? in_sizes[0] : -1, out_size, ws_size, (size_t)WS_END); grid = -1; return; }
        int dev = 0, cus = 0, per_cu = 0;
        if (hipGetDevice(&dev) != hipSuccess || hipDeviceGetAttribute(&cus, hipDeviceAttributeMultiprocessorCount, dev) != hipSuccess) { grid = -1; return; }
        if (hipFuncSetAttribute((const void*)fwd_megakernel, hipFuncAttributeMaxDynamicSharedMemorySize, LDS_BYTES) != hipSuccess) { fprintf(stderr, "kernel_launch: hipFuncSetAttribute failed\n"); grid = -1; return; }
        if (hipOccupancyMaxActiveBlocksPerMultiprocessor(&per_cu, (const void*)fwd_megakernel, NTHR, LDS_BYTES) != hipSuccess || per_cu < 1) { fprintf(stderr, "kernel_launch: occupancy query gave %d\n", per_cu); per_cu = 1; }
        (void)hipGetLastError();
        grid = cus * per_cu;
    }
    if (grid < 0) return;
    Args a{};
    const float** p = (const float**)&a;
    for (int i = 0; i < 19; ++i) p[i] = (const float*)d_in[i];
    a.out = (float*)d_out; a.ws = (unsigned char*)d_ws; a.ph_lo = 0; a.ph_hi = 13;

    if (hipMemsetAsync((char*)d_ws + WS_CTL, 0, WS_STAT + STAT_BYTES, stream) != hipSuccess) { fprintf(stderr, "kernel_launch: memset failed\n"); return; }
    void* args[] = {&a};
    hipError_t e = hipLaunchCooperativeKernel((const void*)fwd_megakernel, dim3(grid), dim3(NTHR), args, LDS_BYTES, stream);
    if (e != hipSuccess) fprintf(stderr, "cooperative launch failed: %s (grid %d)\n", hipGetErrorString(e), grid);
}
```

```cpp
#include <hip/hip_runtime.h>
#include <hip/hip_cooperative_groups.h>
#include <cstdio>
#include <cstdint>
namespace cg = cooperative_groups;
namespace pg8 {
#define PG8_LAS __attribute__((address_space(3)))
typedef unsigned short bf16_t;
typedef short bf16x8 __attribute__((ext_vector_type(8)));
typedef float f32x4 __attribute__((ext_vector_type(4)));
typedef unsigned u32x4 __attribute__((ext_vector_type(4)));
constexpr int BM = 256, BK = 64, HALF = 128, HTB = HALF * BK * 2  , STAGE_BYTES = 8 * HTB, NXCD = 8, WGM = 8;

__host__ __device__ __forceinline__ int lds_byte(int r, int c) { const int st = (r >> 4) * 2 + (c >> 5), rr = r & 15, cc = c & 31, ob = rr * 64 + cc * 2; return st * 1024 + (ob ^ (((ob >> 9) & 1) << 5)); }
__host__ __device__ __forceinline__ void stage_rc(int b, int& R, int& C) { const int st = b / 1024, sb = b % 1024, swz = sb ^ (((sb >> 9) & 1) << 5); R = (st >> 1) * 16 + swz / 64; C = (st & 1) * 32 + (swz % 64) / 2; }
__host__ __device__ __forceinline__ int perm32(int rho) { const int n = rho >> 4, i = rho & 15; return 8 * (i >> 2) + 4 * n + (i & 3); }

struct Unit { int pm, pn; };
struct Gemm { const bf16_t* A; const bf16_t* Bt; int M, N, K; };

struct StaticOrder {
    int nM, nN, nwg, G, c;
    __host__ __device__ void init(int M, int N, int G_, int c_) { nM = M / BM; nN = N / BM; nwg = nM * nN; G = G_; c = c_; }
    __host__ __device__ bool next(int i, Unit& u) const {
        const long L = (long)i * G + c; if (L >= nwg) return false;
        int wgid = (int)L; { const int q = nwg / NXCD, r = nwg % NXCD, xcd = wgid % NXCD, off = wgid / NXCD; wgid = (xcd < r ? xcd * (q + 1) : r * (q + 1) + (xcd - r) * q) + off; }
        const int nig = WGM * nN, gid = wgid / nig, fm = gid * WGM, gsz = (nM - fm) < WGM ? (nM - fm) : WGM;
        u.pm = fm + ((wgid % nig) % gsz); u.pn = (wgid % nig) / gsz; return true;
    }
    __device__ __forceinline__ void a_ready(const Unit&) const {}
    __device__ __forceinline__ void done(const Unit&) const {}
};

typedef __bf16 bf16x2_t __attribute__((ext_vector_type(2)));
typedef float f32x2_t __attribute__((ext_vector_type(2)));
__device__ __forceinline__ unsigned cvt_pk_bf16_safe(float lo, float hi) { const f32x2_t f = {lo, hi}; const bf16x2_t r = __builtin_convertvector(f, bf16x2_t); return __builtin_bit_cast(unsigned, r); }
__device__ __forceinline__ unsigned cvt_pk_bf16(float lo, float hi) { unsigned r; asm volatile("v_cvt_pk_bf16_f32 %0, %1, %2" : "=v"(r) : "v"(lo), "v"(hi)); return r; }
__device__ __forceinline__ u32x4 pack8s(const f32x4 v0, const f32x4 v1) { u32x4 w; w.x = cvt_pk_bf16_safe(v0[0], v0[1]); w.y = cvt_pk_bf16_safe(v0[2], v0[3]); w.z = cvt_pk_bf16_safe(v1[0], v1[1]); w.w = cvt_pk_bf16_safe(v1[2], v1[3]); return w; }
__device__ __forceinline__ u32x4 pack8(const f32x4 v0, const f32x4 v1) { u32x4 w; w.x = cvt_pk_bf16(v0[0], v0[1]); w.y = cvt_pk_bf16(v0[2], v0[3]); w.z = cvt_pk_bf16(v1[0], v1[1]); w.w = cvt_pk_bf16(v1[2], v1[3]); return w; }
__device__ __forceinline__ float bf_lo(unsigned w) { return __uint_as_float(w << 16); }
__device__ __forceinline__ float bf_hi(unsigned w) { return __uint_as_float(w & 0xffff0000u); }
__device__ __forceinline__ float sigm(float x) { return __builtin_amdgcn_rcpf(1.0f + __expf(-x)); }

struct Order {
    int nM, nN, nwg, G, c, lat;
    __device__ void init(int M, int N, int G_, int c_, int lat_) { nM = M / BM; nN = N / BM; nwg = nM * nN; G = G_; c = c_; lat = lat_; }
    __device__ bool next(int i, Unit& u) const {
        const long L = (long)i * G + c; if (L >= nwg) return false;
        int wgid = (int)L; { const int q = nwg / NXCD, r = nwg % NXCD, xcd = wgid % NXCD, off = wgid / NXCD; wgid = (xcd < r ? xcd * (q + 1) : r * (q + 1) + (xcd - r) * q) + off; }
        const int nig = WGM * nN, gid = wgid / nig, fm = gid * WGM, gsz = (nM - fm) < WGM ? (nM - fm) : WGM;
        int pm = fm + ((wgid % nig) % gsz); u.pn = (wgid % nig) / gsz;
        if (lat) pm = pm + (pm >> 5) + 1;
        u.pm = pm; return true;
    }
    __device__ __forceinline__ void a_ready(const Unit&) const {}
    __device__ __forceinline__ void done(const Unit&) const {}
};

struct EpiIn {
    static constexpr bool PERM = true, AFTER_DRAIN = false;
    bf16_t *CQ, *CKV, *KRR, *HGq, *HGff, *HGfb, *HGi, *HGg, *GATE;
    unsigned long long *SQ, *SKV; const float *RC, *RS;
    __device__ __forceinline__ void operator()(const f32x4 (&acc)[2][2][4][2], const Unit& u, int wr, int wc, int fr, int fq) const {
        const int pn = u.pn, pm = u.pm, bt = pm / 33; const bool isctx = (pm - bt * 33) == 0;
        if (pn < 3) {
            unsigned long long* S = pn < 2 ? SQ : SKV;
#pragma unroll
            for (int ai = 0; ai < 2; ++ai)
#pragma unroll
                for (int m = 0; m < 4; ++m) { float sq = 0.f;
#pragma unroll
                    for (int bj = 0; bj < 2; ++bj)
#pragma unroll
                        for (int n = 0; n < 2; ++n) { const f32x4 v = acc[ai][bj][m][n]; sq += (v[0] * v[0] + v[1] * v[1]) + (v[2] * v[2] + v[3] * v[3]); }
                    sq += __shfl_xor(sq, 16); sq += __shfl_xor(sq, 32);
                    if (fq == 0) (void)__hip_atomic_fetch_add(S + pm * BM + wr * 64 + fr + ai * HALF + m * 16, (unsigned long long)(sq * 4294967296.f), __ATOMIC_RELAXED, __HIP_MEMORY_SCOPE_AGENT); }
        }
        if (pn == 3) {
            const int lc = wc * 32 + 8 * fq; if (lc >= 64) return;
            const int i0 = lc >> 1, tt = pm - 33 * bt - 1;
#pragma unroll
            for (int ai = 0; ai < 2; ++ai)
#pragma unroll
                for (int m = 0; m < 4; ++m) { const int rl = wr * 64 + fr + ai * HALF + m * 16; f32x4 v0 = acc[ai][0][m][0], v1 = acc[ai][0][m][1];
                    if (!isctx) { const int t = tt * BM + rl; const f32x4 cs = *(const f32x4*)(RC + t * 32 + i0), sn = *(const f32x4*)(RS + t * 32 + i0); f32x4 x, y;
                        x[0] = v0[0] * cs[0] - v0[1] * sn[0]; x[1] = v0[1] * cs[0] + v0[0] * sn[0]; x[2] = v0[2] * cs[1] - v0[3] * sn[1]; x[3] = v0[3] * cs[1] + v0[2] * sn[1];
                        y[0] = v1[0] * cs[2] - v1[1] * sn[2]; y[1] = v1[1] * cs[2] + v1[0] * sn[2]; y[2] = v1[2] * cs[3] - v1[3] * sn[3]; y[3] = v1[3] * cs[3] + v1[2] * sn[3];
                        v0 = x; v1 = y; }
                    *(u32x4*)(KRR + (size_t)(pm * BM + rl) * 64 + lc) = pack8(v0, v1); }
            return; }
        bf16_t* base; int ldc, colt, act = 0, rowt = pm * BM, maxcol = 256;
        if (pn < 2) { base = CQ; ldc = 512; colt = pn * 256; }
        else if (pn == 2) { base = CKV; ldc = 256; colt = 0; }
        else if (pn == 3) { base = KRR; ldc = 64; colt = 0; maxcol = 64; }
        else if (pn < 8) { base = HGq; ldc = 1024; colt = (pn - 4) * 256; act = 1; }
        else if (pn < 12) { base = HGff; ldc = 1024; colt = (pn - 8) * 256; }
        else if (pn < 16) { base = HGfb; ldc = 1024; colt = (pn - 12) * 256; }
        else if (pn < 20) { base = HGi; ldc = 1024; colt = (pn - 16) * 256; }
        else if (pn < 24) { if (isctx) return; base = HGg; ldc = 1024; colt = (pn - 20) * 256; act = 2; }
        else { if (isctx) return; base = GATE; ldc = 4096; colt = (pn - 24) * 256; act = 3; rowt = (pm - bt - 1) * BM; }
        const int row0 = rowt + wr * 64 + fr, lc0 = wc * 32 + 8 * fq;
#pragma unroll
        for (int ai = 0; ai < 2; ++ai)
#pragma unroll
            for (int m = 0; m < 4; ++m) { bf16_t* rowp = base + (size_t)(row0 + ai * HALF + m * 16) * ldc + colt + lc0;
#pragma unroll
                for (int bj = 0; bj < 2; ++bj) { if (lc0 + bj * HALF >= maxcol) continue;
                    f32x4 v0 = acc[ai][bj][m][0], v1 = acc[ai][bj][m][1];
                    if (act == 1) {
#pragma unroll
                        for (int e = 0; e < 4; ++e) { v0[e] = v0[e] * sigm(v0[e]) * 0.08838834764831845f; v1[e] = v1[e] * sigm(v1[e]) * 0.08838834764831845f; } }
                    else if (act == 2) {
#pragma unroll
                        for (int e = 0; e < 4; ++e) { v0[e] = v0[e] * sigm(v0[e]); v1[e] = v1[e] * sigm(v1[e]); } }
                    else if (act == 3) {
#pragma unroll
                        for (int e = 0; e < 4; ++e) { v0[e] = sigm(v0[e]); v1[e] = sigm(v1[e]); } }
                    *(u32x4*)(rowp + bj * HALF) = pack8(v0, v1); } }
    }
};
struct EpiQ {
    static constexpr bool PERM = true, AFTER_DRAIN = false;
    bf16_t* Q; const float* RC; const float* RS; const unsigned long long* SQ;
    __device__ __forceinline__ void operator()(const f32x4 (&acc)[2][2][4][2], const Unit& u, int wr, int wc, int fr, int fq) const {
        const int pm = u.pm, bt = pm / 33, mt = pm - bt - 1, tt = pm - 33 * bt - 1;
        const int row0 = wr * 64 + fr;
#pragma unroll
        for (int bj = 0; bj < 2; ++bj) {
            const int c0 = u.pn * BM + bj * HALF + wc * 32 + 8 * fq; const int cm = c0 % 192; const bool rope = cm >= 128; const int j0 = (cm - 128) >> 1;
#pragma unroll
            for (int ai = 0; ai < 2; ++ai)
#pragma unroll
                for (int m = 0; m < 4; ++m) { const int rl = row0 + ai * HALF + m * 16;
                    const float rs = rsqrtf((float)__hip_atomic_load(SQ + pm * BM + rl, __ATOMIC_RELAXED, __HIP_MEMORY_SCOPE_AGENT) * (2.3283064365386963e-10f / 512.f) + 1e-6f);
                    f32x4 v0 = acc[ai][bj][m][0] * rs, v1 = acc[ai][bj][m][1] * rs;
                    if (rope) { const int t = tt * BM + rl; const f32x4 cs = *(const f32x4*)(RC + t * 32 + j0), sn = *(const f32x4*)(RS + t * 32 + j0);
                        f32x4 a, b;
                        a[0] = v0[0] * cs[0] - v0[1] * sn[0]; a[1] = v0[1] * cs[0] + v0[0] * sn[0]; a[2] = v0[2] * cs[1] - v0[3] * sn[1]; a[3] = v0[3] * cs[1] + v0[2] * sn[1];
                        b[0] = v1[0] * cs[2] - v1[1] * sn[2]; b[1] = v1[1] * cs[2] + v1[0] * sn[2]; b[2] = v1[2] * cs[3] - v1[3] * sn[3]; b[3] = v1[3] * cs[3] + v1[2] * sn[3];
                        v0 = a; v1 = b; }
                    *(u32x4*)(Q + (size_t)(mt * BM + rl) * 1536 + c0) = pack8(v0, v1); } }
    }
};
struct EpiKV {
    static constexpr bool PERM = true, AFTER_DRAIN = false;
    bf16_t *KN, *VV; const unsigned long long* SKV;
    __device__ __forceinline__ void operator()(const f32x4 (&acc)[2][2][4][2], const Unit& u, int wr, int wc, int fr, int fq) const {
        const int row0 = u.pm * BM + wr * 64 + fr, col0 = u.pn * 128 + wc * 32 + 8 * fq;
#pragma unroll
        for (int ai = 0; ai < 2; ++ai)
#pragma unroll
            for (int m = 0; m < 4; ++m) { const int r = row0 + ai * HALF + m * 16; const size_t off = (size_t)r * 1024 + col0;
                const float rs = rsqrtf((float)__hip_atomic_load(SKV + r, __ATOMIC_RELAXED, __HIP_MEMORY_SCOPE_AGENT) * (2.3283064365386963e-10f / 256.f) + 1e-6f);
                *(u32x4*)(KN + off) = pack8(acc[ai][0][m][0] * rs, acc[ai][0][m][1] * rs);
                *(u32x4*)(VV + off) = pack8(acc[ai][1][m][0] * rs, acc[ai][1][m][1] * rs); }
    }
};
template <bool ADD> struct EpiGate {
    static constexpr bool PERM = true, AFTER_DRAIN = false;
    bf16_t* O; const bf16_t* G; const bf16_t* A; int goff, lat;
    __device__ __forceinline__ void operator()(const f32x4 (&acc)[2][2][4][2], const Unit& u, int wr, int wc, int fr, int fq) const {
        const int row0 = (lat ? u.pm - u.pm / 33 - 1 : u.pm) * BM + wr * 64 + fr, col0 = u.pn * BM + wc * 32 + 8 * fq;
#pragma unroll
        for (int ai = 0; ai < 2; ++ai)
#pragma unroll
            for (int m = 0; m < 4; ++m) { const size_t r = (size_t)(row0 + ai * HALF + m * 16);
#pragma unroll
                for (int bj = 0; bj < 2; ++bj) { const int c = col0 + bj * HALF; const u32x4 g = *(const u32x4*)(G + r * 4096 + goff + c);
                    f32x4 v0 = acc[ai][bj][m][0], v1 = acc[ai][bj][m][1];
                    v0[0] *= bf_lo(g.x); v0[1] *= bf_hi(g.x); v0[2] *= bf_lo(g.y); v0[3] *= bf_hi(g.y); v1[0] *= bf_lo(g.z); v1[1] *= bf_hi(g.z); v1[2] *= bf_lo(g.w); v1[3] *= bf_hi(g.w);
                    if (ADD) { const u32x4 a = *(const u32x4*)(A + r * 2048 + c);
                        v0[0] += bf_lo(a.x); v0[1] += bf_hi(a.x); v0[2] += bf_lo(a.y); v0[3] += bf_hi(a.y); v1[0] += bf_lo(a.z); v1[1] += bf_hi(a.z); v1[2] += bf_lo(a.w); v1[3] += bf_hi(a.w); }
                    *(u32x4*)(O + r * 2048 + c) = pack8(v0, v1); } }
    }
};
struct EpiPlain {
    static constexpr bool PERM = true, AFTER_DRAIN = false;
    bf16_t* O; int ldc;
    __device__ __forceinline__ void operator()(const f32x4 (&acc)[2][2][4][2], const Unit& u, int wr, int wc, int fr, int fq) const {
        const int row0 = u.pm * BM + wr * 64 + fr, col0 = u.pn * BM + wc * 32 + 8 * fq;
#pragma unroll
        for (int ai = 0; ai < 2; ++ai)
#pragma unroll
            for (int m = 0; m < 4; ++m) { bf16_t* rowp = O + (size_t)(row0 + ai * HALF + m * 16) * ldc + col0;
#pragma unroll
                for (int bj = 0; bj < 2; ++bj) *(u32x4*)(rowp + bj * HALF) = pack8(acc[ai][bj][m][0], acc[ai][bj][m][1]); }
    }
};
struct OrderPanel {
    int G, c;
    __device__ void init(int G_, int c_) { G = G_; c = c_; }
    __device__ bool next(int i, Unit& u) const {
        const int ppx = G >> 6;
        if (ppx == 0 || (G & 63)) return false;
        const int x = c & 7, j = c >> 3, panel = (i * 8 + x) * ppx + (j >> 3);
        if (panel >= 128) return false;
        u.pm = panel; u.pn = j & 7; return true;
    }
    __device__ __forceinline__ void a_ready(const Unit&) const {}
    __device__ __forceinline__ void done(const Unit&) const {}
};
__device__ __forceinline__ void panel_publish(unsigned long long* S, unsigned* cnt, const float (&ss)[2][4], int row0, int fr, int fq) {
    if (fq == 0) {
#pragma unroll
        for (int ai = 0; ai < 2; ++ai)
#pragma unroll
            for (int m = 0; m < 4; ++m) (void)__hip_atomic_fetch_add(S + row0 + ai * HALF + m * 16, (unsigned long long)(ss[ai][m] * 4294967296.f), __ATOMIC_RELAXED, __HIP_MEMORY_SCOPE_AGENT);
    }
    asm volatile("s_waitcnt vmcnt(0)" ::: "memory");
    if (fr == 0 && fq == 0) { (void)__hip_atomic_fetch_add(cnt, 1u, __ATOMIC_RELAXED, __HIP_MEMORY_SCOPE_AGENT);
        unsigned sp = 0; while (__hip_atomic_load(cnt, __ATOMIC_RELAXED, __HIP_MEMORY_SCOPE_AGENT) < 64u) { __builtin_amdgcn_s_sleep(1); if (++sp > (1u << 22)) break; } }
    asm volatile("" ::: "memory");
}
__device__ __forceinline__ float panel_rstd(const unsigned long long* S, int row) {
    const unsigned long long v = __hip_atomic_load(S + row, __ATOMIC_RELAXED, __HIP_MEMORY_SCOPE_AGENT);
    return rsqrtf((float)v * (2.3283064365386963e-10f / 2048.f) + 1e-6f);
}
struct EpiRes1 {
    static constexpr bool PERM = true, AFTER_DRAIN = false;
    const float* X; float* X1; bf16_t* H2; const float* MOD; const float* NG; unsigned long long *S1, *S2; unsigned *C1, *C2;
    __device__ __forceinline__ void operator()(f32x4 (&acc)[2][2][4][2], const Unit& u, int wr, int wc, int fr, int fq) const {
        const int row0 = u.pm * BM + wr * 64 + fr, col0 = u.pn * BM + wc * 32 + 8 * fq; const float* mod = MOD + (u.pm >> 5) * 12288;
        float ss[2][4];
#pragma unroll
        for (int ai = 0; ai < 2; ++ai)
#pragma unroll
            for (int m = 0; m < 4; ++m) { float s = 0.f;
#pragma unroll
                for (int bj = 0; bj < 2; ++bj)
#pragma unroll
                    for (int n = 0; n < 2; ++n) { const f32x4 v = acc[ai][bj][m][n]; s += (v[0] * v[0] + v[1] * v[1]) + (v[2] * v[2] + v[3] * v[3]); }
                s += __shfl_xor(s, 16); s += __shfl_xor(s, 32); ss[ai][m] = s; }
        panel_publish(S1, C1 + 64 * u.pm, ss, row0, fr, fq);
        f32x4 g1[2][2], gt[2][2];
#pragma unroll
        for (int bj = 0; bj < 2; ++bj)
#pragma unroll
            for (int n = 0; n < 2; ++n) { const int c = col0 + bj * HALF + 4 * n; g1[bj][n] = *(const f32x4*)(NG + 2048 + c); gt[bj][n] = *(const f32x4*)(mod + 2 * 2048 + c); }
#pragma unroll
        for (int ai = 0; ai < 2; ++ai)
#pragma unroll
            for (int m = 0; m < 4; ++m) { const int r = row0 + ai * HALF + m * 16; const float rs = panel_rstd(S1, r); float s = 0.f;
#pragma unroll
                for (int bj = 0; bj < 2; ++bj)
#pragma unroll
                    for (int n = 0; n < 2; ++n) { const size_t off = (size_t)r * 2048 + col0 + bj * HALF + 4 * n; const f32x4 xv = *(const f32x4*)(X + off);
                        const f32x4 v = xv + gt[bj][n] * (acc[ai][bj][m][n] * rs * g1[bj][n]); acc[ai][bj][m][n] = v; *(f32x4*)(X1 + off) = v;
                        s += (v[0] * v[0] + v[1] * v[1]) + (v[2] * v[2] + v[3] * v[3]); }
                s += __shfl_xor(s, 16); s += __shfl_xor(s, 32); ss[ai][m] = s; }
        panel_publish(S2, C2 + 64 * u.pm, ss, row0, fr, fq);
#pragma unroll
        for (int bj = 0; bj < 2; ++bj) { f32x4 g2[2], sh[2], sc[2];
#pragma unroll
            for (int n = 0; n < 2; ++n) { const int c = col0 + bj * HALF + 4 * n; g2[n] = *(const f32x4*)(NG + 2 * 2048 + c); sh[n] = *(const f32x4*)(mod + 3 * 2048 + c); sc[n] = *(const f32x4*)(mod + 4 * 2048 + c) + 1.0f; }
#pragma unroll
            for (int ai = 0; ai < 2; ++ai)
#pragma unroll
                for (int m = 0; m < 4; ++m) { const int r = row0 + ai * HALF + m * 16; const float rs = panel_rstd(S2, r);
                    const f32x4 h0 = (acc[ai][bj][m][0] * rs * g2[0]) * sc[0] + sh[0], h1 = (acc[ai][bj][m][1] * rs * g2[1]) * sc[1] + sh[1];
                    *(u32x4*)(H2 + (size_t)r * 2048 + col0 + bj * HALF) = pack8(h0, h1); } }
    }
};
struct EpiRes2 {
    static constexpr bool PERM = true, AFTER_DRAIN = false;
    float* OUT; const float* MOD; const float* NG; unsigned long long* S3; unsigned* C3;
    __device__ __forceinline__ void operator()(f32x4 (&acc)[2][2][4][2], const Unit& u, int wr, int wc, int fr, int fq) const {
        const int row0 = u.pm * BM + wr * 64 + fr, col0 = u.pn * BM + wc * 32 + 8 * fq; const float* mod = MOD + (u.pm >> 5) * 12288;
        float ss[2][4];
#pragma unroll
        for (int ai = 0; ai < 2; ++ai)
#pragma unroll
            for (int m = 0; m < 4; ++m) { float s = 0.f;
#pragma unroll
                for (int bj = 0; bj < 2; ++bj)
#pragma unroll
                    for (int n = 0; n < 2; ++n) { const f32x4 v = acc[ai][bj][m][n]; s += (v[0] * v[0] + v[1] * v[1]) + (v[2] * v[2] + v[3] * v[3]); }
                s += __shfl_xor(s, 16); s += __shfl_xor(s, 32); ss[ai][m] = s; }
        panel_publish(S3, C3 + 64 * u.pm, ss, row0, fr, fq);
        f32x4 g3[2][2], gt[2][2];
#pragma unroll
        for (int bj = 0; bj < 2; ++bj)
#pragma unroll
            for (int n = 0; n < 2; ++n) { const int c = col0 + bj * HALF + 4 * n; g3[bj][n] = *(const f32x4*)(NG + 3 * 2048 + c); gt[bj][n] = *(const f32x4*)(mod + 5 * 2048 + c); }
#pragma unroll
        for (int ai = 0; ai < 2; ++ai)
#pragma unroll
            for (int m = 0; m < 4; ++m) { const int r = row0 + ai * HALF + m * 16; const float rs = panel_rstd(S3, r);
#pragma unroll
                for (int bj = 0; bj < 2; ++bj)
#pragma unroll
                    for (int n = 0; n < 2; ++n) { const size_t off = (size_t)r * 2048 + col0 + bj * HALF + 4 * n; const f32x4 xv = *(const f32x4*)(OUT + off);
                        *(f32x4*)(OUT + off) = xv + gt[bj][n] * (acc[ai][bj][m][n] * rs * g3[bj][n]); } }
    }
};
struct EpiSwiGLU {
    static constexpr bool PERM = true, AFTER_DRAIN = false;
    bf16_t* O;
    __device__ __forceinline__ void operator()(const f32x4 (&acc)[2][2][4][2], const Unit& u, int wr, int wc, int fr, int fq) const {
        typedef unsigned u32x2v __attribute__((ext_vector_type(2)));
        const int row0 = u.pm * BM + wr * 64 + fr, col0 = u.pn * 128 + wc * 16 + 4 * fq;
#pragma unroll
        for (int ai = 0; ai < 2; ++ai)
#pragma unroll
            for (int m = 0; m < 4; ++m) { bf16_t* rowp = O + (size_t)(row0 + ai * HALF + m * 16) * 5632 + col0;
#pragma unroll
                for (int bj = 0; bj < 2; ++bj) { const f32x4 a = acc[ai][bj][m][0], b = acc[ai][bj][m][1]; f32x4 r;
#pragma unroll
                    for (int e = 0; e < 4; ++e) r[e] = a[e] * sigm(a[e]) * b[e];
                    u32x2v w; w.x = cvt_pk_bf16(r[0], r[1]); w.y = cvt_pk_bf16(r[2], r[3]); *(u32x2v*)(rowp + bj * 64) = w; } }
    }
};

template <class Epi, class Sched, bool ALIGN_EPI = false, bool SP2 = false>
__device__ __forceinline__ void gemm_phase(PG8_LAS unsigned char* lds, const Gemm g, const Sched& S, const Epi& E, const int wid) {
    int lane; asm volatile("v_mbcnt_lo_u32_b32 %0, -1, 0\n\tv_mbcnt_hi_u32_b32 %0, -1, %0" : "=v"(lane)); const int tid = wid * 64 + lane, wr = wid >> 2, wc = wid & 3, fr = lane & 15, fq = lane >> 4;
    const int K = g.K, nt = K / BK;
    unsigned voffA[2], voffB[2];
#pragma unroll
    for (int i = 0; i < 2; ++i) { int R, C; stage_rc(tid * 16 + i * 8192, R, C); const int Rb = Epi::PERM ? ((R & ~31) + perm32(R & 31)) : R;
        voffA[i] = (unsigned)(R * K + C) * 2u; voffB[i] = (unsigned)(Rb * K + C) * 2u; }
    const size_t kstep = (size_t)(BK * 2);
    const size_t hstep = (size_t)HALF * K * 2;
    const size_t tstep = 2 * hstep;
    const unsigned ldsw = (unsigned)wid * 1024u;
    const int aoff = lds_byte(wr * 64 + fr, fq * 8), boff = lds_byte(wc * 32 + fr, fq * 8);
#define PG8_SA(b, h) (((b) * 2 + (h)) * HTB)
#define PG8_SB(b, h) ((4 + (b) * 2 + (h)) * HTB)
#define PG8_STAGE(bufoff, gbase, voff) do { _Pragma("unroll") for (int _i = 0; _i < 2; ++_i) \
        __builtin_amdgcn_global_load_lds((const unsigned*)((const char*)(gbase) + (voff)[_i]), (PG8_LAS unsigned*)(lds + (bufoff) + ldsw + _i * 8192), 16, 0, 0); } while (0)
#define PG8_LDA(dst, b, h) do { _Pragma("unroll") for (int m = 0; m < 4; ++m) _Pragma("unroll") for (int k = 0; k < 2; ++k) dst[m][k] = *(const PG8_LAS bf16x8*)(lds + PG8_SA(b, h) + aoff + m * 2048 + k * 1024); } while (0)
#define PG8_LDB(dst, b, h) do { _Pragma("unroll") for (int n = 0; n < 2; ++n) _Pragma("unroll") for (int k = 0; k < 2; ++k) dst[n][k] = *(const PG8_LAS bf16x8*)(lds + PG8_SB(b, h) + boff + n * 2048 + k * 1024); } while (0)
#define PG8_MMA(ai, bj, At, Bt) do { __builtin_amdgcn_s_setprio(1); _Pragma("unroll") for (int m = 0; m < 4; ++m) _Pragma("unroll") for (int n = 0; n < 2; ++n) _Pragma("unroll") for (int k = 0; k < 2; ++k) \
        acc[ai][bj][m][n] = __builtin_amdgcn_mfma_f32_16x16x32_bf16(Bt[n][k], At[m][k], acc[ai][bj][m][n], 0, 0, 0); __builtin_amdgcn_s_setprio(0); } while (0)
#define PG8_WAIT_V(n) asm volatile("s_waitcnt vmcnt(" #n ")" ::: "memory")
#define PG8_WAIT_L(n) asm volatile("s_waitcnt lgkmcnt(" #n ")" ::: "memory")
#define PG8_BAR __builtin_amdgcn_s_barrier()
#define PG8_SCHED __builtin_amdgcn_sched_barrier(0)
    Unit cur, nxt; int ui = 0;
    if (!S.next(0, cur)) return;
    f32x4 acc[2][2][4][2];
#pragma unroll
    for (int a = 0; a < 2; ++a)
#pragma unroll
        for (int b = 0; b < 2; ++b)
#pragma unroll
            for (int m = 0; m < 4; ++m)
#pragma unroll
                for (int n = 0; n < 2; ++n) acc[a][b][m][n] = (f32x4){0.f, 0.f, 0.f, 0.f};
    bf16x8 At[4][2], B0[2][2], B1[2][2];
    const char* cA = (const char*)g.A + (size_t)cur.pm * tstep; const char* cB = (const char*)g.Bt + (size_t)cur.pn * tstep;
    S.a_ready(cur);
    if constexpr (SP2) {
        PG8_STAGE(PG8_SB(0, 0), cB, voffB); PG8_STAGE(PG8_SB(0, 1), cB + hstep, voffB); PG8_STAGE(PG8_SA(0, 0), cA, voffA); PG8_STAGE(PG8_SA(0, 1), cA + hstep, voffA);
        if (wr == 1) PG8_BAR;
        PG8_WAIT_V(2); PG8_BAR;
        PG8_STAGE(PG8_SB(1, 0), cB + kstep, voffB); PG8_STAGE(PG8_SA(1, 0), cA + kstep, voffA); PG8_STAGE(PG8_SB(1, 1), cB + hstep + kstep, voffB);
        PG8_WAIT_V(6); PG8_BAR;
    } else {
        PG8_STAGE(PG8_SB(0, 0), cB, voffB); PG8_STAGE(PG8_SA(0, 0), cA, voffA); PG8_STAGE(PG8_SB(0, 1), cB + hstep, voffB); PG8_STAGE(PG8_SA(0, 1), cA + hstep, voffA);
        if (wr == 1) PG8_BAR;
        PG8_WAIT_V(4); PG8_BAR;
        PG8_STAGE(PG8_SB(1, 0), cB + kstep, voffB); PG8_STAGE(PG8_SA(1, 0), cA + kstep, voffA); PG8_STAGE(PG8_SB(1, 1), cB + hstep + kstep, voffB);
        PG8_WAIT_V(6); PG8_BAR;
    }
    for (;;) {
        const bool has_next = S.next(ui + 1, nxt);
        const char* nA = has_next ? (const char*)g.A + (size_t)nxt.pm * tstep : cA; const char* nB = has_next ? (const char*)g.Bt + (size_t)nxt.pn * tstep : cB;
        for (int t = 0; t < nt; t += 2) {
            const bool last = (t == nt - 2);
            const char* a1 = cA + (size_t)(t + 1) * kstep;
            const char* a2 = last ? nA : cA + (size_t)(t + 2) * kstep; const char* b2 = last ? nB : cB + (size_t)(t + 2) * kstep;
            const char* a3 = a2 + kstep; const char* b3 = b2 + kstep;
            if (last && has_next) S.a_ready(nxt);
            if constexpr (SP2) {
            PG8_LDB(B0, 0, 0); PG8_LDB(B1, 0, 1); PG8_SCHED; PG8_LDA(At, 0, 0); PG8_STAGE(PG8_SA(1, 1), a1 + hstep, voffA);
            PG8_WAIT_V(8); PG8_WAIT_L(0); PG8_BAR; PG8_MMA(0, 0, At, B0); PG8_MMA(0, 1, At, B1); PG8_BAR; PG8_SCHED;
            PG8_LDA(At, 0, 1); PG8_STAGE(PG8_SB(0, 0), b2, voffB); PG8_STAGE(PG8_SB(0, 1), b2 + hstep, voffB); PG8_STAGE(PG8_SA(0, 0), a2, voffA);
            PG8_WAIT_V(8); PG8_WAIT_L(0); PG8_BAR; PG8_MMA(1, 0, At, B0); PG8_MMA(1, 1, At, B1); PG8_BAR; PG8_SCHED;
            PG8_LDB(B0, 1, 0); PG8_LDB(B1, 1, 1); PG8_SCHED; PG8_LDA(At, 1, 0); PG8_STAGE(PG8_SA(0, 1), a2 + hstep, voffA);
            PG8_WAIT_V(8); PG8_WAIT_L(0); PG8_BAR; PG8_MMA(0, 0, At, B0); PG8_MMA(0, 1, At, B1); PG8_BAR; PG8_SCHED;
            PG8_LDA(At, 1, 1); PG8_STAGE(PG8_SB(1, 0), b3, voffB); PG8_STAGE(PG8_SB(1, 1), b3 + hstep, voffB); PG8_STAGE(PG8_SA(1, 0), a3, voffA);
            PG8_WAIT_V(8); PG8_WAIT_L(0); PG8_BAR; PG8_MMA(1, 0, At, B0); PG8_MMA(1, 1, At, B1); PG8_BAR; PG8_SCHED;
            } else {
            PG8_LDB(B0, 0, 0); PG8_SCHED; PG8_LDA(At, 0, 0); PG8_STAGE(PG8_SA(1, 1), a1 + hstep, voffA);
            PG8_WAIT_L(8); PG8_BAR; PG8_WAIT_L(0); PG8_MMA(0, 0, At, B0); PG8_BAR; PG8_SCHED;
            PG8_LDB(B1, 0, 1); PG8_STAGE(PG8_SB(0, 0), b2, voffB);
            PG8_BAR; PG8_WAIT_L(0); PG8_MMA(0, 1, At, B1); PG8_BAR;
            PG8_LDA(At, 0, 1); PG8_STAGE(PG8_SA(0, 0), a2, voffA);
            PG8_BAR; PG8_WAIT_L(0); PG8_MMA(1, 0, At, B0); PG8_BAR; PG8_SCHED;
            PG8_STAGE(PG8_SB(0, 1), b2 + hstep, voffB);
            PG8_WAIT_V(6); PG8_BAR; PG8_MMA(1, 1, At, B1); PG8_BAR;
            PG8_LDB(B0, 1, 0); PG8_SCHED; PG8_LDA(At, 1, 0); PG8_STAGE(PG8_SA(0, 1), a2 + hstep, voffA);
            PG8_WAIT_L(8); PG8_BAR; PG8_WAIT_L(0); PG8_MMA(0, 0, At, B0); PG8_BAR; PG8_SCHED;
            PG8_LDB(B1, 1, 1); PG8_STAGE(PG8_SB(1, 0), b3, voffB);
            PG8_BAR; PG8_WAIT_L(0); PG8_MMA(0, 1, At, B1); PG8_BAR;
            PG8_LDA(At, 1, 1); PG8_STAGE(PG8_SA(1, 0), a3, voffA);
            PG8_BAR; PG8_WAIT_L(0); PG8_MMA(1, 0, At, B0); PG8_BAR; PG8_SCHED;
            PG8_STAGE(PG8_SB(1, 1), b3 + hstep, voffB);
            PG8_WAIT_V(6); PG8_BAR; PG8_MMA(1, 1, At, B1); PG8_BAR;
            }
        }
        if constexpr (ALIGN_EPI) { if (wr == 0) PG8_BAR; }
        if constexpr (!Epi::AFTER_DRAIN) { asm volatile("s_nop 15\n\ts_nop 15" ::: "memory");   E(acc, cur, wr, wc, fr, fq); S.done(cur); }
        if (!has_next) break;
#pragma unroll
        for (int a = 0; a < 2; ++a)
#pragma unroll
            for (int b = 0; b < 2; ++b)
#pragma unroll
                for (int m = 0; m < 4; ++m)
#pragma unroll
                    for (int n = 0; n < 2; ++n) acc[a][b][m][n] = (f32x4){0.f, 0.f, 0.f, 0.f};
        cur = nxt; cA = nA; cB = nB; ++ui;
        if constexpr (ALIGN_EPI) { if (wr == 1) PG8_BAR; }
    }
    PG8_WAIT_V(0);
    if constexpr (!ALIGN_EPI) { if (wr == 0) PG8_BAR; }
    PG8_BAR;
    if constexpr (Epi::AFTER_DRAIN) { E.fused(acc, cur, wr, wc, fr, fq, lds, wid, lane); S.done(cur); }
#undef PG8_SA
#undef PG8_SB
#undef PG8_STAGE
#undef PG8_LDA
#undef PG8_LDB
#undef PG8_MMA
#undef PG8_WAIT_V
#undef PG8_WAIT_L
#undef PG8_BAR
#undef PG8_SCHED
}
}

#define PG8_SP2 true
#define PG8_ALIGN true
#define LAS __attribute__((address_space(3)))
typedef unsigned short bf16;
typedef short bf16x8 __attribute__((ext_vector_type(8)));
typedef short s16x4 __attribute__((ext_vector_type(4)));
typedef float f32x4 __attribute__((ext_vector_type(4)));
typedef float f32x16 __attribute__((ext_vector_type(16)));
typedef unsigned u32x4 __attribute__((ext_vector_type(4)));
typedef unsigned u32x2 __attribute__((ext_vector_type(2)));
using pg8::cvt_pk_bf16; using pg8::bf_lo; using pg8::bf_hi; using pg8::sigm;

constexpr int DM = 2048, NB = 4, SEQ = 8192, CTXL = 256, RB = SEQ + CTXL, MR = NB * RB, ML = NB * SEQ;
constexpr int NINP = 10240, DFF = 5632, NW = 8, NTHR = 512;
constexpr float RMS_EPS = 1e-6f;
constexpr float QSCALE = 0.07216878364870322f * 1.4426950408889634f;
constexpr size_t MiB = 1u << 20;
constexpr size_t WS_CTL = 0, WS_MOD = 1664 * 1024, WS_ROPEC = 2 * MiB, WS_ROPES = WS_ROPEC + MiB;
constexpr size_t WS_STAT = 64 * 1024, STAT_BYTES = 1536 * 1024, STAT_SQ = 917504;
static_assert(WS_STAT + STAT_BYTES <= WS_MOD && WS_MOD + 5 * 12288 * 4 <= WS_ROPEC, "control / statistics / modulation / rope map");
constexpr size_t WS_WUQ = 4 * MiB, WS_WUKV = 6 * MiB, WS_WBRA = 8 * MiB, WS_WBRH = 12 * MiB, WS_WOUT = 16 * MiB;
constexpr size_t WS_WIN = 24 * MiB, WS_CQ = 64 * MiB, WS_CKV = 97 * MiB, WS_KRR = WS_CKV + (size_t)MR * 256 * 2  , WS_ATTO = 24 * MiB;
constexpr size_t WS_KR = 118 * MiB;
constexpr size_t WS_H = 124 * MiB, WS_KN = 124 * MiB, WS_VV = 190 * MiB, WS_HGO = 124 * MiB, WS_ACT = 124 * MiB;
constexpr size_t WS_HGFF = 256 * MiB, WS_HGFB = 322 * MiB, WS_HGG = 388 * MiB, WS_HGQ = 454 * MiB, WS_HGI = 520 * MiB, WS_M1 = 124 * MiB, WS_T = 454 * MiB;
constexpr size_t WS_GATE = 586 * MiB, WS_OUTL = 586 * MiB, WS_H2 = 714 * MiB, WS_Y = 586 * MiB;
constexpr size_t WS_Q = 842 * MiB, WS_WFIN = 938 * MiB, WS_WFOUT = 982 * MiB, WS_END = 1004 * MiB;
static_assert(WS_KRR + (size_t)MR * 64 * 2 <= WS_KR && WS_KR + (size_t)MR * 64 * 2 <= WS_H && WS_CQ + (size_t)MR * 512 * 2 <= WS_CKV, "ws map 1");
static_assert(WS_H + (size_t)MR * DM * 2 <= WS_HGFF && WS_HGI + (size_t)MR * 1024 * 2 <= WS_GATE && WS_GATE + (size_t)ML * 4096 * 2 <= WS_Q && WS_Q + (size_t)ML * 1536 * 2 <= WS_WFIN, "ws map 2");
static_assert(WS_ACT + (size_t)ML * DFF * 2 <= WS_GATE && WS_WFIN + (size_t)2 * DFF * DM * 2 <= WS_WFOUT && WS_WFOUT + (size_t)DM * DFF * 2 <= WS_END, "ws map 3");
static_assert(WS_WIN + (size_t)NINP * DM * 2 <= WS_CQ && WS_ATTO + (size_t)ML * 1024 * 2 <= WS_CKV, "ws map 4");
constexpr int LDS_BYTES = 147456, LDS_MISC = 135168;

struct Args {
    const float *x, *c, *ctx, *c_ctx, *w_mod, *b_mod, *norm_g, *w_in, *q_norm, *kv_norm, *w_uq, *w_ukv, *hgrn_lb, *o_norm, *w_br_mla, *w_br_hgrn, *w_out, *w_ffn_in, *w_ffn_out;
    float* out; unsigned char* ws; int ph_lo, ph_hi;
};

__device__ __forceinline__ float wave_sum(float v) {
#pragma unroll
    for (int o = 1; o < 64; o <<= 1) v += __shfl_xor(v, o);
    return v;
}
#define LDS_WAIT() asm volatile("s_waitcnt lgkmcnt(0)" ::: "memory")
__device__ __forceinline__ int lane_now() { int l; asm volatile("v_mbcnt_lo_u32_b32 %0, -1, 0\n\tv_mbcnt_hi_u32_b32 %0, -1, %0" : "=v"(l)); return l; }

__device__ __forceinline__ int src_col(int mode, int n) {
    if (mode == 1) { if (n < 768) return n; if (n < 832) { const int j = n - 768; return 768 + (j >> 1) + 32 * (j & 1); } return n < 1024 ? -1 : n - 192; }
    if (mode == 2) { const int h = n / 192, c = n - h * 192; if (c < 128) return n; const int j = c - 128; return h * 192 + 128 + (j >> 1) + 32 * (j & 1); }
    if (mode == 3) { const int g = n >> 3, e = n & 7; return e < 4 ? 4 * g + e : DFF + 4 * g + (e - 4); }
    return n;
}
__device__ __forceinline__ void transpose_item(const float* W, int K, int Nsrc, int Ndst, bf16* WT, LAS float* scr, int item, int lane, int mode, float scale, const float* kscale = nullptr) {
    const int nblk = Ndst / 32, kb = item / nblk, nb = item - kb * nblk, k0 = 64 * kb, n0 = 32 * nb;
    const int sc = src_col(mode, n0 + (lane & 31));
#pragma unroll 8
    for (int i = 0; i < 32; ++i) { const int kk = 2 * i + (lane >> 5); scr[kk * 33 + (lane & 31)] = sc >= 0 ? W[(size_t)(k0 + kk) * Nsrc + sc] * (kscale ? scale * kscale[k0 + kk] : scale) : 0.f; }
    LDS_WAIT(); asm volatile("" ::: "memory");
    const int c = lane & 7;
#pragma unroll
    for (int j = 0; j < 4; ++j) { const int n = (lane >> 3) + 8 * j; const LAS float* s = scr + (8 * c) * 33 + n;
        u32x4 o; o.x = cvt_pk_bf16(s[0 * 33], s[1 * 33]); o.y = cvt_pk_bf16(s[2 * 33], s[3 * 33]); o.z = cvt_pk_bf16(s[4 * 33], s[5 * 33]); o.w = cvt_pk_bf16(s[6 * 33], s[7 * 33]);
        *(u32x4*)(WT + (size_t)(n0 + n) * K + k0 + 8 * c) = o; }
    LDS_WAIT(); asm volatile("" ::: "memory");
}
__device__ __forceinline__ void mod_gemv_item(const Args& a, LAS unsigned char* lds, int strip, int tid) {
    LAS float* S5 = (LAS float*)lds;
    LAS float* PART = (LAS float*)(lds + 40960);
    const int wave = tid >> 6, lane = tid & 63;
    for (int i = tid; i < 5 * DM; i += NTHR) { const int v = i / DM, k = i - v * DM; const float xv = v < 4 ? a.c[v * DM + k] : a.c_ctx[k]; S5[i] = xv * sigm(xv); }
    __syncthreads();
    const int kq = lane >> 4, c4 = lane & 15, cbase = strip * 64; const float* W = a.w_mod + cbase + 4 * c4;
    f32x4 acc[5];
#pragma unroll
    for (int v = 0; v < 5; ++v) acc[v] = (f32x4){0.f, 0.f, 0.f, 0.f};
    const int kb = wave * 256;
#pragma unroll 8
    for (int k = 0; k < 256; k += 4) { const int kk = kb + k + kq; const f32x4 w = *(const f32x4*)(W + (size_t)kk * (6 * DM));
#pragma unroll
        for (int v = 0; v < 5; ++v) acc[v] += w * S5[v * DM + kk]; }
#pragma unroll
    for (int v = 0; v < 5; ++v)
#pragma unroll
        for (int e = 0; e < 4; ++e) { float x = acc[v][e]; x += __shfl_xor(x, 16); x += __shfl_xor(x, 32); if (kq == 0) PART[(wave * 5 + v) * 64 + 4 * c4 + e] = x; }
    __syncthreads();
    if (tid < 320) { const int v = tid >> 6; float s = 0.f;
#pragma unroll
        for (int w = 0; w < 8; ++w) s += PART[(w * 5 + v) * 64 + lane];
        const int c0 = strip * 64 + lane; float* MOD = (float*)(a.ws + WS_MOD); MOD[v * (6 * DM) + c0] = s + a.b_mod[c0]; }
    __syncthreads();
}

__device__ __forceinline__ void p1_row(const Args& a, int R, int lane) {
    const int b = R / RB, r = R - b * RB; const float* src = r < CTXL ? a.ctx + ((size_t)b * CTXL + r) * DM : a.x + ((size_t)b * SEQ + (r - CTXL)) * DM;
    const float* MOD = (const float*)(a.ws + WS_MOD) + (r < CTXL ? 4 : b) * (6 * DM);
    f32x4 v[8]; float ss = 0.f;
#pragma unroll
    for (int j = 0; j < 8; ++j) { v[j] = *(const f32x4*)(src + 4 * (lane + 64 * j)); ss += (v[j][0] * v[j][0] + v[j][1] * v[j][1]) + (v[j][2] * v[j][2] + v[j][3] * v[j][3]); }
    const float rstd = rsqrtf(wave_sum(ss) * (1.f / DM) + RMS_EPS);
    bf16* H = (bf16*)(a.ws + WS_H) + (size_t)R * DM;
#pragma unroll
    for (int j = 0; j < 8; ++j) { const int c = 4 * (lane + 64 * j); const f32x4 g = *(const f32x4*)(a.norm_g + c), sh = *(const f32x4*)(MOD + c), sc = *(const f32x4*)(MOD + DM + c);
        f32x4 h;
#pragma unroll
        for (int e = 0; e < 4; ++e) h[e] = (v[j][e] * rstd * g[e]) * (1.f + sc[e]) + sh[e];
        u32x2 w; w.x = cvt_pk_bf16(h[0], h[1]); w.y = cvt_pk_bf16(h[2], h[3]); *(u32x2*)(H + c) = w; }
}
__device__ __forceinline__ void p3_row(const Args& a, int R, int lane) {
    const int b = R / RB, r = R - b * RB;
    { bf16* p = (bf16*)(a.ws + WS_CQ) + (size_t)R * 512 + 8 * lane; const u32x4 w = *(const u32x4*)p;
      float f[8] = {bf_lo(w.x), bf_hi(w.x), bf_lo(w.y), bf_hi(w.y), bf_lo(w.z), bf_hi(w.z), bf_lo(w.w), bf_hi(w.w)}; float ss = 0.f;
#pragma unroll
      for (int e = 0; e < 8; ++e) ss += f[e] * f[e];
      const float rstd = rsqrtf(wave_sum(ss) * (1.f / 512.f) + RMS_EPS); const float* g = a.q_norm + 8 * lane;
      u32x4 o; o.x = cvt_pk_bf16(f[0] * rstd * g[0], f[1] * rstd * g[1]); o.y = cvt_pk_bf16(f[2] * rstd * g[2], f[3] * rstd * g[3]); o.z = cvt_pk_bf16(f[4] * rstd * g[4], f[5] * rstd * g[5]); o.w = cvt_pk_bf16(f[6] * rstd * g[6], f[7] * rstd * g[7]);
      *(u32x4*)p = o; }
    { bf16* p = (bf16*)(a.ws + WS_CKV) + (size_t)R * 256 + 4 * lane; const u32x2 w = *(const u32x2*)p;
      float f[4] = {bf_lo(w.x), bf_hi(w.x), bf_lo(w.y), bf_hi(w.y)}; float ss = (f[0] * f[0] + f[1] * f[1]) + (f[2] * f[2] + f[3] * f[3]);
      const float rstd = rsqrtf(wave_sum(ss) * (1.f / 256.f) + RMS_EPS); const float* g = a.kv_norm + 4 * lane;
      u32x2 o; o.x = cvt_pk_bf16(f[0] * rstd * g[0], f[1] * rstd * g[1]); o.y = cvt_pk_bf16(f[2] * rstd * g[2], f[3] * rstd * g[3]);
      *(u32x2*)p = o; }
    if (lane < 32) { const bf16* p = (const bf16*)(a.ws + WS_KRR) + (size_t)R * 64; float x1 = __uint_as_float((unsigned)p[lane] << 16), x2 = __uint_as_float((unsigned)p[lane + 32] << 16);
      if (r >= CTXL) { const int t = r - CTXL; const float cs = ((const float*)(a.ws + WS_ROPEC))[t * 32 + lane], sn = ((const float*)(a.ws + WS_ROPES))[t * 32 + lane];
          const float y1 = x1 * cs - x2 * sn, y2 = x2 * cs + x1 * sn; x1 = y1; x2 = y2; }
      ((unsigned*)(a.ws + WS_KR))[(size_t)R * 32 + lane] = cvt_pk_bf16(x1, x2); }
}
__device__ __forceinline__ void p6_part(const Args& a, int m, int coff, int gidx) {
    const int b = m >> 13, R = b * RB + CTXL + (m & 8191);
    const size_t off = (size_t)R * 1024 + coff;
    const bf16* of = (const bf16*)(a.ws + WS_HGFF) + off; const bf16* ob = (const bf16*)(a.ws + WS_HGFB) + off; const bf16* hg = (const bf16*)(a.ws + WS_HGG) + off;
    float o[16]; float ss = 0.f;
#pragma unroll
    for (int q = 0; q < 2; ++q) { const u32x4 x = *(const u32x4*)(of + 8 * q), y = *(const u32x4*)(ob + 8 * q);
        o[8 * q + 0] = bf_lo(x.x) + bf_lo(y.x); o[8 * q + 1] = bf_hi(x.x) + bf_hi(y.x); o[8 * q + 2] = bf_lo(x.y) + bf_lo(y.y); o[8 * q + 3] = bf_hi(x.y) + bf_hi(y.y);
        o[8 * q + 4] = bf_lo(x.z) + bf_lo(y.z); o[8 * q + 5] = bf_hi(x.z) + bf_hi(y.z); o[8 * q + 6] = bf_lo(x.w) + bf_lo(y.w); o[8 * q + 7] = bf_hi(x.w) + bf_hi(y.w); }
#pragma unroll
    for (int e = 0; e < 16; ++e) ss += o[e] * o[e];
    ss += __shfl_xor(ss, 1); ss += __shfl_xor(ss, 2); ss += __shfl_xor(ss, 4);
    const float rstd = rsqrtf(ss * (1.f / 128.f) + RMS_EPS); const float* g = a.o_norm + 16 * gidx;
    bf16* dst = (bf16*)(a.ws + WS_HGFF) + off;
#pragma unroll
    for (int q = 0; q < 2; ++q) { const u32x4 gt = *(const u32x4*)(hg + 8 * q);
        const float s[8] = {bf_lo(gt.x), bf_hi(gt.x), bf_lo(gt.y), bf_hi(gt.y), bf_lo(gt.z), bf_hi(gt.z), bf_lo(gt.w), bf_hi(gt.w)}; float r[8];
#pragma unroll
        for (int e = 0; e < 8; ++e) r[e] = o[8 * q + e] * rstd * g[8 * q + e] * s[e];
        u32x4 w; w.x = cvt_pk_bf16(r[0], r[1]); w.y = cvt_pk_bf16(r[2], r[3]); w.z = cvt_pk_bf16(r[4], r[5]); w.w = cvt_pk_bf16(r[6], r[7]);
        *(u32x4*)(dst + 8 * q) = w; }
}
__device__ __forceinline__ void p9_row(const Args& a, int m, int lane) {
    const int b = m >> 13; const float* MOD = (const float*)(a.ws + WS_MOD) + b * (6 * DM);
    const bf16* ol = (const bf16*)(a.ws + WS_OUTL) + (size_t)m * DM; const float* xr = a.x + (size_t)m * DM; float* x1r = a.out + (size_t)m * DM; bf16* h2 = (bf16*)(a.ws + WS_H2) + (size_t)m * DM;
    float o[32]; float ss = 0.f;
#pragma unroll
    for (int j = 0; j < 4; ++j) { const u32x4 w = *(const u32x4*)(ol + 8 * lane + 512 * j);
        o[8 * j + 0] = bf_lo(w.x); o[8 * j + 1] = bf_hi(w.x); o[8 * j + 2] = bf_lo(w.y); o[8 * j + 3] = bf_hi(w.y); o[8 * j + 4] = bf_lo(w.z); o[8 * j + 5] = bf_hi(w.z); o[8 * j + 6] = bf_lo(w.w); o[8 * j + 7] = bf_hi(w.w); }
#pragma unroll
    for (int e = 0; e < 32; ++e) ss += o[e] * o[e];
    const float rstd1 = rsqrtf(wave_sum(ss) * (1.f / DM) + RMS_EPS);
    float ss2 = 0.f;
#pragma unroll
    for (int j = 0; j < 4; ++j) { const int c = 8 * lane + 512 * j;
#pragma unroll
        for (int q = 0; q < 2; ++q) { const f32x4 xv = *(const f32x4*)(xr + c + 4 * q), g = *(const f32x4*)(a.norm_g + DM + c + 4 * q), gt = *(const f32x4*)(MOD + 2 * DM + c + 4 * q);
#pragma unroll
            for (int e = 0; e < 4; ++e) { const float v = xv[e] + gt[e] * (o[8 * j + 4 * q + e] * rstd1 * g[e]); o[8 * j + 4 * q + e] = v; ss2 += v * v; }
            *(f32x4*)(x1r + c + 4 * q) = (f32x4){o[8 * j + 4 * q], o[8 * j + 4 * q + 1], o[8 * j + 4 * q + 2], o[8 * j + 4 * q + 3]}; } }
    const float rstd2 = rsqrtf(wave_sum(ss2) * (1.f / DM) + RMS_EPS);
#pragma unroll
    for (int j = 0; j < 4; ++j) { const int c = 8 * lane + 512 * j; float h[8];
#pragma unroll
        for (int q = 0; q < 2; ++q) { const f32x4 g = *(const f32x4*)(a.norm_g + 2 * DM + c + 4 * q), sh = *(const f32x4*)(MOD + 3 * DM + c + 4 * q), sc = *(const f32x4*)(MOD + 4 * DM + c + 4 * q);
#pragma unroll
            for (int e = 0; e < 4; ++e) h[4 * q + e] = (o[8 * j + 4 * q + e] * rstd2 * g[e]) * (1.f + sc[e]) + sh[e]; }
        u32x4 w; w.x = cvt_pk_bf16(h[0], h[1]); w.y = cvt_pk_bf16(h[2], h[3]); w.z = cvt_pk_bf16(h[4], h[5]); w.w = cvt_pk_bf16(h[6], h[7]);
        *(u32x4*)(h2 + c) = w; }
}
__device__ __forceinline__ void p12_row(const Args& a, int m, int lane) {
    const int b = m >> 13; const float* MOD = (const float*)(a.ws + WS_MOD) + b * (6 * DM);
    const bf16* yr = (const bf16*)(a.ws + WS_Y) + (size_t)m * DM; float* x1r = a.out + (size_t)m * DM;
    float o[32]; float ss = 0.f;
#pragma unroll
    for (int j = 0; j < 4; ++j) { const u32x4 w = *(const u32x4*)(yr + 8 * lane + 512 * j);
        o[8 * j + 0] = bf_lo(w.x); o[8 * j + 1] = bf_hi(w.x); o[8 * j + 2] = bf_lo(w.y); o[8 * j + 3] = bf_hi(w.y); o[8 * j + 4] = bf_lo(w.z); o[8 * j + 5] = bf_hi(w.z); o[8 * j + 6] = bf_lo(w.w); o[8 * j + 7] = bf_hi(w.w); }
#pragma unroll
    for (int e = 0; e < 32; ++e) ss += o[e] * o[e];
    const float rstd = rsqrtf(wave_sum(ss) * (1.f / DM) + RMS_EPS);
#pragma unroll
    for (int j = 0; j < 4; ++j) { const int c = 8 * lane + 512 * j;
#pragma unroll
        for (int q = 0; q < 2; ++q) { const f32x4 xv = *(const f32x4*)(x1r + c + 4 * q), g = *(const f32x4*)(a.norm_g + 3 * DM + c + 4 * q), gt = *(const f32x4*)(MOD + 5 * DM + c + 4 * q); f32x4 r;
#pragma unroll
            for (int e = 0; e < 4; ++e) r[e] = xv[e] + gt[e] * (o[8 * j + 4 * q + e] * rstd * g[e]);
            *(f32x4*)(x1r + c + 4 * q) = r; } }
}
namespace att {
constexpr int LDQ = 1536, LDK = 1024, LDO = 1024;
constexpr int SHM_V = 16384, SHM_K = 16384, SHM_KR = 8192, OFF_K = 32768, OFF_KR = 65536, OFF_WS = 81920, OFF_QR = 83968;
#define KSWZ(row, colB) ((row) * 256 + ((colB) ^ (((row) & 7) << 4)))
#define KRSWZ(row, colB) ((row) * 128 + ((colB) ^ ((((row) >> 1) & 7) << 4)))
#define SBAR() __builtin_amdgcn_sched_barrier(0)
#define ILV2() do { __builtin_amdgcn_sched_group_barrier(0x100, 8, 1); _Pragma("unroll") for (int g_ = 0; g_ < 12; ++g_) { __builtin_amdgcn_sched_group_barrier(0x008, 1, 1); __builtin_amdgcn_sched_group_barrier(0x100, 2, 1); __builtin_amdgcn_sched_group_barrier(0x002, 5, 1); } _Pragma("unroll") for (int g_ = 0; g_ < 4; ++g_) { __builtin_amdgcn_sched_group_barrier(0x008, 1, 1); __builtin_amdgcn_sched_group_barrier(0x002, 5, 1); } } while (0)
#define ILV1() do { __builtin_amdgcn_sched_group_barrier(0x100, 6, 0); _Pragma("unroll") for (int g_ = 0; g_ < 24; ++g_) { __builtin_amdgcn_sched_group_barrier(0x008, 1, 0); __builtin_amdgcn_sched_group_barrier(0x100, 1, 0); __builtin_amdgcn_sched_group_barrier(0x002, 5, 0); } } while (0)
__device__ __forceinline__ int crow(int r, int hi) { return (r & 3) + 8 * (r >> 2) + 4 * hi; }
__device__ __forceinline__ int v_st(int k, int c) { const int kk = (k & ~0xC) | ((k & 4) << 1) | ((k & 8) >> 1); return ((kk >> 3) * 4 + (c >> 5)) * 512 + ((kk & 7) * 32 + (c & 31)) * 2; }
__device__ __forceinline__ int v_rd_base(int lane) { return ((lane & 3) << 3) | (((lane >> 2) & 3) << 6) | (((lane >> 4) & 1) << 5) | (((lane >> 5) & 1) << 8); }
constexpr int v_rd_off(int d0, int ks, int half) { return d0 * 512 + ks * 4096 + half * 2048; }
template <int OFF> __device__ __forceinline__ s16x4 tr_read(int vb) { return __builtin_amdgcn_ds_read_tr16_b64_v4i16((LAS s16x4*)(unsigned)(vb + OFF)); }
template <int D0> __device__ __forceinline__ void pv_one(f32x16& od, int vb, bf16x8 pa0, bf16x8 pa1, bf16x8 pa2, bf16x8 pa3) {
  const s16x4 l0 = tr_read<v_rd_off(D0, 0, 0)>(vb), h0 = tr_read<v_rd_off(D0, 0, 1)>(vb), l1 = tr_read<v_rd_off(D0, 1, 0)>(vb), h1 = tr_read<v_rd_off(D0, 1, 1)>(vb);
  const s16x4 l2 = tr_read<v_rd_off(D0, 2, 0)>(vb), h2 = tr_read<v_rd_off(D0, 2, 1)>(vb), l3 = tr_read<v_rd_off(D0, 3, 0)>(vb), h3 = tr_read<v_rd_off(D0, 3, 1)>(vb);
#define PK(L, H) (bf16x8){L[0], L[1], L[2], L[3], H[0], H[1], H[2], H[3]}
  od = __builtin_amdgcn_mfma_f32_32x32x16_bf16(pa0, PK(l0, h0), od, 0, 0, 0);
  od = __builtin_amdgcn_mfma_f32_32x32x16_bf16(pa1, PK(l1, h1), od, 0, 0, 0);
  od = __builtin_amdgcn_mfma_f32_32x32x16_bf16(pa2, PK(l2, h2), od, 0, 0, 0);
  od = __builtin_amdgcn_mfma_f32_32x32x16_bf16(pa3, PK(l3, h3), od, 0, 0, 0);
#undef PK
}
__device__ __forceinline__ void qkt(f32x16& p0, f32x16& p1, const LAS unsigned char* Ks, const LAS unsigned char* KRs, const LAS unsigned char* QR_l, const bf16x8* qr, int r32, int hi, const float negm) {
#pragma unroll
  for (int r = 0; r < 16; ++r) { p0[r] = negm; p1[r] = negm; }
#pragma unroll
  for (int d0 = 0; d0 < 8; ++d0) { const int cb = (d0 * 16 + hi * 8) * 2;
    const bf16x8 b0 = *(const LAS bf16x8*)(Ks + KSWZ(r32, cb)); const bf16x8 b1 = *(const LAS bf16x8*)(Ks + KSWZ(32 + r32, cb));
    bf16x8 qf; if (d0 < 6) qf = qr[d0 < 6 ? d0 : 0]; else qf = *(const LAS bf16x8*)(QR_l + (d0 - 6) * 1024);
    p0 = __builtin_amdgcn_mfma_f32_32x32x16_bf16(b0, qf, p0, 0, 0, 0); p1 = __builtin_amdgcn_mfma_f32_32x32x16_bf16(b1, qf, p1, 0, 0, 0); }
#pragma unroll
  for (int d0 = 0; d0 < 4; ++d0) { const int cb = (d0 * 16 + hi * 8) * 2;
    const bf16x8 b0 = *(const LAS bf16x8*)(KRs + KRSWZ(r32, cb)); const bf16x8 b1 = *(const LAS bf16x8*)(KRs + KRSWZ(32 + r32, cb));
    const bf16x8 qf = *(const LAS bf16x8*)(QR_l + (2 + d0) * 1024);
    p0 = __builtin_amdgcn_mfma_f32_32x32x16_bf16(b0, qf, p0, 0, 0, 0); p1 = __builtin_amdgcn_mfma_f32_32x32x16_bf16(b1, qf, p1, 0, 0, 0); }
}
__device__ __forceinline__ void partialSM(f32x16& p0, f32x16& p1, float& m_reg, float& alpha, const float m_issue, const bool first = false) {
  float pmax = p0[0];
#pragma unroll
  for (int r = 1; r < 16; ++r) pmax = fmaxf(pmax, p0[r]);
#pragma unroll
  for (int r = 0; r < 16; ++r) pmax = fmaxf(pmax, p1[r]);
  { auto rr = __builtin_amdgcn_permlane32_swap(__float_as_uint(pmax), __float_as_uint(pmax), false, false); pmax = fmaxf(__uint_as_float(rr[0]), __uint_as_float(rr[1])); }
  if (first) { alpha = 1.f; m_reg = pmax + m_issue;
#pragma unroll
    for (int r = 0; r < 16; ++r) { p0[r] = p0[r] - pmax; p1[r] = p1[r] - pmax; }
    return; }
  const float delta = m_reg - m_issue;
  if (__builtin_expect(__all(pmax - delta <= 8.f) && __all(delta == 0.f), 1)) alpha = 1.f;
  else { const float smax = pmax + m_issue; const float mn = (smax - m_reg <= 8.f) ? m_reg : fmaxf(m_reg, smax); alpha = __builtin_amdgcn_exp2f(m_reg - mn); m_reg = mn; const float sh = mn - m_issue;
#pragma unroll
    for (int r = 0; r < 16; ++r) { p0[r] = p0[r] - sh; p1[r] = p1[r] - sh; } }
}
__device__ __forceinline__ void finishSM(f32x16& p0, f32x16& p1, float alpha, float& l_reg, bf16x8& pa0, bf16x8& pa1, bf16x8& pa2, bf16x8& pa3) {
#pragma unroll
  for (int r = 0; r < 16; ++r) { p0[r] = __builtin_amdgcn_exp2f(p0[r]); p1[r] = __builtin_amdgcn_exp2f(p1[r]); }
  float ps = 0.f;
#pragma unroll
  for (int r = 0; r < 16; ++r) ps += p0[r];
#pragma unroll
  for (int r = 0; r < 16; ++r) ps += p1[r];
  { auto rr = __builtin_amdgcn_permlane32_swap(__float_as_uint(ps), __float_as_uint(ps), false, false); ps = __uint_as_float(rr[0]) + __uint_as_float(rr[1]); }
  l_reg = l_reg * alpha + ps;
#define PK4(P, BASE, OUT) do { unsigned a0 = pg8::cvt_pk_bf16_safe(P[BASE + 0], P[BASE + 1]), a1 = pg8::cvt_pk_bf16_safe(P[BASE + 2], P[BASE + 3]);   \
    unsigned b0 = pg8::cvt_pk_bf16_safe(P[BASE + 4], P[BASE + 5]), b1 = pg8::cvt_pk_bf16_safe(P[BASE + 6], P[BASE + 7]);                              \
    auto r0 = __builtin_amdgcn_permlane32_swap(a0, b0, false, false); auto r1 = __builtin_amdgcn_permlane32_swap(a1, b1, false, false); \
    u32x4 w = {r0[0], r1[0], r0[1], r1[1]}; OUT = *reinterpret_cast<bf16x8*>(&w); } while (0)
  PK4(p0, 0, pa0); PK4(p0, 8, pa1); PK4(p1, 0, pa2); PK4(p1, 8, pa3);
#undef PK4
}
__device__ __forceinline__ void pv_d0(f32x16* o, int vb, bf16x8 pa0, bf16x8 pa1, bf16x8 pa2, bf16x8 pa3) {
  pv_one<0>(o[0], vb, pa0, pa1, pa2, pa3); pv_one<1>(o[1], vb, pa0, pa1, pa2, pa3); pv_one<2>(o[2], vb, pa0, pa1, pa2, pa3); pv_one<3>(o[3], vb, pa0, pa1, pa2, pa3);
}
__device__ __forceinline__ void attn_unit(const bf16* __restrict__ Qb, const bf16* __restrict__ Kh, const bf16* __restrict__ KRb, const bf16* __restrict__ Vh, bf16* __restrict__ Ob, int seq, LAS unsigned char* lds, const int wid) {
  const int lane = lane_now(), tid = wid * 64 + lane, r32 = lane & 31, hi = lane >> 5;
  LAS unsigned char* V_lds = lds; LAS unsigned char* K_lds = lds + OFF_K; LAS unsigned char* KR_lds = lds + OFF_KR;
  LAS float* wsf = (LAS float*)(lds + OFF_WS) + wid * 64; LAS float* li_l = wsf; LAS float* al_l = wsf + 32;
  float m_reg = -1e30f, l_reg = 0.f; f32x16 o[4];
#pragma unroll
  for (int d = 0; d < 4; ++d)
#pragma unroll
    for (int r = 0; r < 16; ++r) o[d][r] = 0.f;
  bf16x8 qr[6];
  const bf16* Qw = Qb + (size_t)(wid * 32 + r32) * LDQ + hi * 8;
#pragma unroll
  for (int d0 = 0; d0 < 6; ++d0) qr[d0] = *(const bf16x8*)(Qw + d0 * 16);
  LAS unsigned char* QR_l = lds + OFF_QR + (wid * 384 + lane) * 16;
#pragma unroll
  for (int d0 = 0; d0 < 6; ++d0) *(LAS bf16x8*)(QR_l + d0 * 1024) = *(const bf16x8*)(Qw + (6 + d0) * 16);
  const int sr = tid >> 4, sc = (tid & 15) * 8, vst0 = v_st(sr, sc), vst1 = v_st(32 + sr, sc);
  const int krr = tid >> 3, krc = (tid & 7) * 8;
  const int vb0 = (int)(unsigned)(uintptr_t)V_lds + v_rd_base(lane);
  bf16x8 sv0, sv1, sk0, sk1, skr;
#define SLOAD(k0) do { sv0 = *(const bf16x8*)(Vh + (size_t)((k0) + sr) * LDK + sc); sv1 = *(const bf16x8*)(Vh + (size_t)((k0) + 32 + sr) * LDK + sc); \
    sk0 = *(const bf16x8*)(Kh + (size_t)((k0) + sr) * LDK + sc); sk1 = *(const bf16x8*)(Kh + (size_t)((k0) + 32 + sr) * LDK + sc); \
    skr = *(const bf16x8*)(KRb + (size_t)((k0) + krr) * 64 + krc); } while (0)
#define SWRITE_V(b) do { *(LAS bf16x8*)(V_lds + (b) * SHM_V + vst0) = sv0; *(LAS bf16x8*)(V_lds + (b) * SHM_V + vst1) = sv1; } while (0)
#define SWRITE_K(b) do { *(LAS bf16x8*)(K_lds + (b) * SHM_K + KSWZ(sr, sc * 2)) = sk0; *(LAS bf16x8*)(K_lds + (b) * SHM_K + KSWZ(32 + sr, sc * 2)) = sk1; \
    *(LAS bf16x8*)(KR_lds + (b) * SHM_KR + KRSWZ(krr, krc * 2)) = skr; } while (0)
#define RESC(a) do { if (__any((a) < 1.f)) { if (hi == 0) al_l[r32] = (a); LDS_WAIT(); \
    _Pragma("unroll") for (int r = 0; r < 16; ++r) { const float al = al_l[crow(r, hi)]; _Pragma("unroll") for (int d = 0; d < 4; ++d) o[d][r] *= al; } } } while (0)
  f32x16 pA0, pA1, pB0, pB1; float alA, alB; bf16x8 pa0, pa1, pa2, pa3; const int NT = seq / 64;
  SLOAD(0); SWRITE_K(0); SWRITE_V(0); __syncthreads();
  qkt(pA0, pA1, K_lds, KR_lds, QR_l, qr, r32, hi, 0.f); partialSM(pA0, pA1, m_reg, alA, 0.f, true);
  SLOAD(64); SWRITE_K(1); SWRITE_V(1); __syncthreads();
  for (int j = 1; j + 1 < NT; j += 2) {
    SBAR(); const float mB_ = m_reg; qkt(pB0, pB1, K_lds + SHM_K, KR_lds + SHM_KR, QR_l, qr, r32, hi, -mB_);
    finishSM(pA0, pA1, alA, l_reg, pa0, pa1, pa2, pa3); ILV1(); SBAR();
    SLOAD((j + 1) * 64); SBAR();
    pv_d0(o, vb0, pa0, pa1, pa2, pa3); partialSM(pB0, pB1, m_reg, alB, mB_); ILV2(); SBAR();
    SWRITE_K(0); RESC(alB); __syncthreads(); SWRITE_V(0); SBAR();
    const float mA_ = m_reg; qkt(pA0, pA1, K_lds, KR_lds, QR_l, qr, r32, hi, -mA_);
    finishSM(pB0, pB1, alB, l_reg, pa0, pa1, pa2, pa3); ILV1(); SBAR();
    SLOAD((j + 2) * 64); SBAR();
    pv_d0(o, vb0 + SHM_V, pa0, pa1, pa2, pa3); partialSM(pA0, pA1, m_reg, alA, mA_); ILV2(); SBAR();
    SWRITE_K(1); RESC(alA); __syncthreads(); SWRITE_V(1); SBAR();
  }
  SBAR(); const float mT_ = m_reg; qkt(pB0, pB1, K_lds + SHM_K, KR_lds + SHM_KR, QR_l, qr, r32, hi, -mT_);
  finishSM(pA0, pA1, alA, l_reg, pa0, pa1, pa2, pa3); SBAR();
  pv_d0(o, vb0, pa0, pa1, pa2, pa3); partialSM(pB0, pB1, m_reg, alB, mT_);
  __syncthreads(); RESC(alB);
  finishSM(pB0, pB1, alB, l_reg, pa0, pa1, pa2, pa3); SBAR();
  pv_d0(o, vb0 + SHM_V, pa0, pa1, pa2, pa3);
  if (hi == 0) li_l[r32] = l_reg; LDS_WAIT();
  bf16* Ow = Ob + (size_t)(wid * 32) * LDO;
#pragma unroll
  for (int r = 0; r < 16; ++r) { const int orow = crow(r, hi); const float rl = __builtin_amdgcn_rcpf(li_l[orow]);
#pragma unroll
    for (int d0 = 0; d0 < 4; ++d0) Ow[(size_t)orow * LDO + d0 * 32 + r32] = (bf16)(pg8::cvt_pk_bf16_safe(o[d0][r] * rl, 0.f) & 0xffffu); }
  __syncthreads();
#undef SLOAD
#undef SWRITE_K
#undef SWRITE_V
#undef RESC
}
}
namespace hg {
constexpr int QD_OFF = 0, KD_OFF = 17408, KTT_OFF = 34816, HVT_OFF = 53248, SC_OFF = 71680, SEG_OFF = 80896, DEC_OFF = 84992;
__device__ __forceinline__ void scan_unit(const Args& a, int unit, LAS unsigned char* lds, const int wave) {
  const int b = unit >> 4, h = (unit >> 1) & 7, dir = unit & 1;
  const int lane = lane_now(), l15 = lane & 15, quad = lane >> 4;
  const bf16* HQ = (const bf16*)(a.ws + WS_HGQ) + h * 128; const bf16* HF = (const bf16*)(a.ws + (dir ? WS_HGFB : WS_HGFF)) + h * 128; const bf16* HV = (const bf16*)(a.ws + WS_HGI) + h * 128;
  bf16* HO = (bf16*)(a.ws + (dir ? WS_HGFB : WS_HGFF)) + h * 128;
  float lbv[2], oml[2];
#pragma unroll
  for (int e = 0; e < 2; ++e) { const int idx = dir * 1024 + h * 128 + 2 * lane + e; const float a0 = a.hgrn_lb[idx], a1 = a.hgrn_lb[2048 + idx]; lbv[e] = 1.f / (1.f + __expf(a1 - a0)); oml[e] = 1.f - lbv[e]; }
  f32x4 S[8];
#pragma unroll
  for (int d = 0; d < 8; ++d) S[d] = (f32x4){0.f, 0.f, 0.f, 0.f};
  unsigned xq[8], xf[8], xv[8];
#define CHUNK_OF(n) (dir ? ((n) < 4 ? 3 - (n) : 135 - (n)) : (n))
#define ROW_OF(c, i) ((size_t)b * RB + 64 * (c) + (dir ? 63 - (i) : (i)))
#define HLOAD(c) do { _Pragma("unroll") for (int r = 0; r < 8; ++r) { const size_t off = ROW_OF(c, 8 * wave + r) * 1024 + 2 * lane; \
      xq[r] = *(const unsigned*)(HQ + off); xf[r] = *(const unsigned*)(HF + off); xv[r] = *(const unsigned*)(HV + off); } } while (0)
  HLOAD(CHUNK_OF(0));
  for (int n = 0; n < 132; ++n) {
    const int c = CHUNK_OF(n); const bool lat = c >= 4;
    float cs[8][2], kk[8][2], qv[8][2]; unsigned hvr[8];
    { float run0 = 0.f, run1 = 0.f;
#pragma unroll
      for (int r = 0; r < 8; ++r) { const float f0 = lbv[0] + oml[0] * sigm(bf_lo(xf[r])), f1 = lbv[1] + oml[1] * sigm(bf_hi(xf[r]));
        run0 += __builtin_amdgcn_logf(f0) * 0.6931471805599453f; run1 += __builtin_amdgcn_logf(f1) * 0.6931471805599453f;     cs[r][0] = run0; cs[r][1] = run1; kk[r][0] = 1.f - f0; kk[r][1] = 1.f - f1;
        qv[r][0] = bf_lo(xq[r]); qv[r][1] = bf_hi(xq[r]); hvr[r] = xv[r]; }
      *(LAS float*)(lds + SEG_OFF + (wave * 128 + 2 * lane) * 4) = run0; *(LAS float*)(lds + SEG_OFF + (wave * 128 + 2 * lane + 1) * 4) = run1; }
    if (n + 1 < 132) HLOAD(CHUNK_OF(n + 1));
    __syncthreads();
    { float pre0 = 0.f, pre1 = 0.f, tot0 = 0.f, tot1 = 0.f;
#pragma unroll
      for (int s = 0; s < 8; ++s) { const float v0 = *(LAS float*)(lds + SEG_OFF + (s * 128 + 2 * lane) * 4), v1 = *(LAS float*)(lds + SEG_OFF + (s * 128 + 2 * lane + 1) * 4);
        tot0 += v0; tot1 += v1; if (s < wave) { pre0 += v0; pre1 += v1; } }
      const float et0 = __expf(tot0), et1 = __expf(tot1);
      unsigned ktp0[4], ktp1[4], hv0[4], hv1[4];
#pragma unroll
      for (int r = 0; r < 8; r += 2) {
        float qd[2][2], kd[2][2], kt[2][2];
#pragma unroll
        for (int rr = 0; rr < 2; ++rr) { const float b0 = cs[r + rr][0] + pre0, b1 = cs[r + rr][1] + pre1;
          qd[rr][0] = qv[r + rr][0] * __expf(b0); qd[rr][1] = qv[r + rr][1] * __expf(b1);
          kd[rr][0] = kk[r + rr][0] * __expf(-b0); kd[rr][1] = kk[r + rr][1] * __expf(-b1);
          kt[rr][0] = kd[rr][0] * et0; kt[rr][1] = kd[rr][1] * et1;
          const int i = 8 * wave + r + rr;
          *(LAS unsigned*)(lds + QD_OFF + i * 272 + lane * 4) = pg8::cvt_pk_bf16_safe(qd[rr][0], qd[rr][1]);
          *(LAS unsigned*)(lds + KD_OFF + i * 272 + lane * 4) = pg8::cvt_pk_bf16_safe(kd[rr][0], kd[rr][1]); }
        ktp0[r >> 1] = pg8::cvt_pk_bf16_safe(kt[0][0], kt[1][0]); ktp1[r >> 1] = pg8::cvt_pk_bf16_safe(kt[0][1], kt[1][1]);
        hv0[r >> 1] = (hvr[r] & 0xffffu) | (hvr[r + 1] << 16); hv1[r >> 1] = (hvr[r] >> 16) | (hvr[r + 1] & 0xffff0000u); }
      *(LAS u32x4*)(lds + KTT_OFF + (2 * lane) * 144 + wave * 16) = (u32x4){ktp0[0], ktp0[1], ktp0[2], ktp0[3]};
      *(LAS u32x4*)(lds + KTT_OFF + (2 * lane + 1) * 144 + wave * 16) = (u32x4){ktp1[0], ktp1[1], ktp1[2], ktp1[3]};
      *(LAS u32x4*)(lds + HVT_OFF + (2 * lane) * 144 + wave * 16) = (u32x4){hv0[0], hv0[1], hv0[2], hv0[3]};
      *(LAS u32x4*)(lds + HVT_OFF + (2 * lane + 1) * 144 + wave * 16) = (u32x4){hv1[0], hv1[1], hv1[2], hv1[3]};
      if (wave == 0) { *(LAS float*)(lds + DEC_OFF + (2 * lane) * 4) = et0; *(LAS float*)(lds + DEC_OFF + (2 * lane + 1) * 4) = et1; } }
    __syncthreads();
    if (lat) {
#pragma unroll
      for (int e = 0; e < 2; ++e) { const int id = 2 * wave + e, it = id >> 2, st = id & 3; f32x4 acc = (f32x4){0.f, 0.f, 0.f, 0.f};
#pragma unroll
        for (int ks = 0; ks < 4; ++ks) { const bf16x8 av = *(const LAS bf16x8*)(lds + QD_OFF + (it * 16 + l15) * 272 + (ks * 32 + quad * 8) * 2);
          const bf16x8 bv = *(const LAS bf16x8*)(lds + KD_OFF + (st * 16 + l15) * 272 + (ks * 32 + quad * 8) * 2);
          acc = __builtin_amdgcn_mfma_f32_16x16x32_bf16(av, bv, acc, 0, 0, 0); }
#pragma unroll
        for (int j = 0; j < 4; ++j) { const int i = it * 16 + quad * 4 + j, s = st * 16 + l15; const float v = s <= i ? acc[j] : 0.f;
          *(LAS unsigned short*)(lds + SC_OFF + i * 144 + s * 2) = (unsigned short)(pg8::cvt_pk_bf16_safe(v, 0.f) & 0xffffu); } }
    }
    __syncthreads();
    { const int vs = 16 * wave;
      bf16x8 hvf[2];
#pragma unroll
      for (int ks = 0; ks < 2; ++ks) hvf[ks] = *(const LAS bf16x8*)(lds + HVT_OFF + (vs + l15) * 144 + (ks * 32 + quad * 8) * 2);
      if (lat) {
        bf16x8 sf[4];
#pragma unroll
        for (int ks = 0; ks < 4; ++ks) { u32x4 w; w.x = pg8::cvt_pk_bf16_safe(S[2 * ks][0], S[2 * ks][1]); w.y = pg8::cvt_pk_bf16_safe(S[2 * ks][2], S[2 * ks][3]); w.z = pg8::cvt_pk_bf16_safe(S[2 * ks + 1][0], S[2 * ks + 1][1]); w.w = pg8::cvt_pk_bf16_safe(S[2 * ks + 1][2], S[2 * ks + 1][3]);
          sf[ks] = __builtin_bit_cast(bf16x8, w); }
#pragma unroll
        for (int it = 0; it < 4; ++it) { f32x4 acc = (f32x4){0.f, 0.f, 0.f, 0.f};
#pragma unroll
          for (int ks = 0; ks < 2; ++ks) { const bf16x8 av = *(const LAS bf16x8*)(lds + SC_OFF + (it * 16 + l15) * 144 + (ks * 32 + quad * 8) * 2);
            acc = __builtin_amdgcn_mfma_f32_16x16x32_bf16(av, hvf[ks], acc, 0, 0, 0); }
#pragma unroll
          for (int ks = 0; ks < 4; ++ks) { const u32x2 lo = *(const LAS u32x2*)(lds + QD_OFF + (it * 16 + l15) * 272 + (ks * 32 + quad * 4) * 2);
            const u32x2 hi2 = *(const LAS u32x2*)(lds + QD_OFF + (it * 16 + l15) * 272 + (ks * 32 + 16 + quad * 4) * 2);
            const u32x4 w = (u32x4){lo.x, lo.y, hi2.x, hi2.y};
            acc = __builtin_amdgcn_mfma_f32_16x16x32_bf16(__builtin_bit_cast(bf16x8, w), sf[ks], acc, 0, 0, 0); }
#pragma unroll
          for (int j = 0; j < 4; ++j) { const int i = it * 16 + quad * 4 + j;
            HO[ROW_OF(c, i) * 1024 + vs + l15] = (bf16)(pg8::cvt_pk_bf16_safe(acc[j], 0.f) & 0xffffu); } }
      }
#pragma unroll
      for (int dt = 0; dt < 8; ++dt) { const f32x4 dc = *(const LAS f32x4*)(lds + DEC_OFF + (16 * dt + 4 * quad) * 4);
        f32x4 sacc = S[dt] * dc;
#pragma unroll
        for (int ks = 0; ks < 2; ++ks) { const bf16x8 av = *(const LAS bf16x8*)(lds + KTT_OFF + (dt * 16 + l15) * 144 + (ks * 32 + quad * 8) * 2);
          sacc = __builtin_amdgcn_mfma_f32_16x16x32_bf16(av, hvf[ks], sacc, 0, 0, 0); }
        S[dt] = sacc; } }
  }
#undef HLOAD
#undef CHUNK_OF
#undef ROW_OF
}
}
#define XB_TMO      128
#define XB_XCNT(j)  (256  + 64 * (j))
#define XB_XSUB(j)  (1280 + 64 * (j))
#define XB_XGEN(j)  (2304 + 64 * (j))
#define XB_TOP      3328
#define XB_TOPGEN   3392
#define XCD_BAR_WORDS 3456
#define XB_SPIN_CAP (1u << 20)
__device__ __forceinline__ unsigned xb_ld(unsigned* p)              { return __hip_atomic_load(p, __ATOMIC_RELAXED, __HIP_MEMORY_SCOPE_AGENT); }
__device__ __forceinline__ unsigned xb_add(unsigned* p, unsigned v) { return __hip_atomic_fetch_add(p, v, __ATOMIC_RELAXED, __HIP_MEMORY_SCOPE_AGENT); }
__device__ __forceinline__ unsigned xb_xcc_id() { return (unsigned)__builtin_amdgcn_s_getreg((3 << 11) | 20) & 0xFu; }
#define XB_SPIN(cond, bar) do { unsigned _sp = 0; while (cond) { __builtin_amdgcn_s_sleep(1); \
    if ((++_sp & 255u) == 0u) { if (xb_ld(&(bar)[XB_TMO])) break; if (_sp > XB_SPIN_CAP) { atomicAdd(&(bar)[XB_TMO], 1u); break; } } } } while (0)
struct XcdBarrier { unsigned* bar; unsigned x; volatile LAS unsigned* st; };
__device__ __forceinline__ XcdBarrier xcd_barrier_post(unsigned* bar, volatile LAS unsigned* st, bool leader) {
    XcdBarrier b; b.bar = bar; b.x = xb_xcc_id(); b.st = st;
    if (leader) (void)xb_add(&bar[XB_XCNT(b.x)], 1u);
    return b;
}
__device__ __forceinline__ void xcd_barrier_complete(unsigned* bar, unsigned x, unsigned& nloc, unsigned& nx) {
    const unsigned G = gridDim.x * gridDim.y * gridDim.z;
    unsigned sum, cnt, mine, sp = 0u;
    for (;;) {
        sum = 0u; cnt = 0u; mine = 0u;
#pragma unroll
        for (unsigned j = 0; j < 16; ++j) { const unsigned c = xb_ld(&bar[XB_XCNT(j)]); sum += c; cnt += (c > 0u) ? 1u : 0u; mine = (j == x) ? c : mine; }
        if (sum == G) break;
        __builtin_amdgcn_s_sleep(1);
        if ((++sp & 255u) == 0u) { if (xb_ld(&bar[XB_TMO])) break; if (sp > XB_SPIN_CAP) { atomicAdd(&bar[XB_TMO], 1u); break; } }
    }
    nloc = mine > 0u ? mine : 1u; nx = cnt > 0u ? cnt : 1u;
}
__device__ __forceinline__ void xcd_barrier(const XcdBarrier& b, bool leader) {
    asm volatile("s_waitcnt vmcnt(0)" ::: "memory");
    __syncthreads();
    if (leader) {
        unsigned* bar = b.bar;
        __builtin_amdgcn_s_waitcnt(0);
        unsigned nloc = b.st[0], nx = b.st[1];
        if (nloc == 0u) { xcd_barrier_complete(bar, b.x, nloc, nx); b.st[0] = nloc; b.st[1] = nx; }
        const unsigned old = xb_add(&bar[XB_XSUB(b.x)], 1u);
        const unsigned gen = old / nloc;
        if (old + 1u == (gen + 1u) * nloc) {
            __builtin_amdgcn_fence(__ATOMIC_RELEASE, "agent");
            asm volatile("s_waitcnt vmcnt(0)" ::: "memory");
            const unsigned og = xb_add(&bar[XB_TOP], 1u);
            const unsigned tg = og / nx;
            if (og + 1u == (tg + 1u) * nx) xb_add(&bar[XB_TOPGEN], 1u);
            else XB_SPIN(xb_ld(&bar[XB_TOPGEN]) == tg, bar);
            __builtin_amdgcn_fence(__ATOMIC_ACQUIRE, "agent");
            xb_add(&bar[XB_XGEN(b.x)], 1u);
            asm volatile("s_waitcnt vmcnt(0)" ::: "memory");
        } else {
            XB_SPIN(xb_ld(&bar[XB_XGEN(b.x)]) == gen, bar);
            __builtin_amdgcn_fence(__ATOMIC_ACQUIRE, "agent");
            asm volatile("s_waitcnt vmcnt(0)" ::: "memory");
        }
    }
    __syncthreads();
}
__device__ __forceinline__ void ffn_transpose_drain(const Args& a, LAS unsigned char* lds, unsigned* ctr, const int wave) {
    constexpr int I_FI = (DM / 64) * (2 * DFF / 32), I_FO = (DFF / 64) * (DM / 32), NIT = I_FI + I_FO;
    LAS unsigned* slot = (LAS unsigned*)(lds + LDS_MISC);
    LAS float* scr = (LAS float*)(lds + wave * 16384);
    const int lane = lane_now();
    for (;;) {
        if (wave == 0 && lane == 0) slot[1] = __hip_atomic_fetch_add(ctr, 8u, __ATOMIC_RELAXED, __HIP_MEMORY_SCOPE_AGENT);
        __syncthreads();
        const int it = (int)slot[1] + wave;
        __syncthreads();
        if (it - wave >= NIT) break;
        if (it < I_FI) transpose_item(a.w_ffn_in, DM, 2 * DFF, 2 * DFF, (bf16*)(a.ws + WS_WFIN), scr, it, lane, 3, 1.f);
        else if (it < NIT) transpose_item(a.w_ffn_out, DFF, DM, DM, (bf16*)(a.ws + WS_WFOUT), scr, it - I_FI, lane, 0, 1.f);
    }
}
__global__ void __launch_bounds__(NTHR, 2) fwd_megakernel(Args a) {
    extern __shared__ __attribute__((aligned(16))) unsigned char lds_raw[];
    LAS unsigned char* lds = (LAS unsigned char*)lds_raw;
    cg::grid_group grid = cg::this_grid();
    const int wave = __builtin_amdgcn_readfirstlane((int)threadIdx.x >> 6);
    const int G = gridDim.x, bx = blockIdx.x;
    const int gw = bx * NW + wave, NGW = G * NW;
    unsigned* ctl = (unsigned*)(a.ws + WS_CTL);
    const int lo = a.ph_lo, hi = a.ph_hi;
#ifdef PROBE_HI
#define IN(k) ((k) < PROBE_HI)
#define SEAMON(k) ((k) < PROBE_HI)
#else
#define IN(k) (lo <= (k) && (k) < hi)
#define SEAMON(k) (IN(k) && IN((k) + 1))
#endif
    { volatile LAS unsigned* st0 = (volatile LAS unsigned*)(lds + LDS_MISC + 16); if (wave == 0 && lane_now() < 2) st0[lane_now()] = 0u; }
    __syncthreads();
    XcdBarrier xbar = xcd_barrier_post(ctl + 1024, (volatile LAS unsigned*)(lds + LDS_MISC + 16), wave == 0 && lane_now() == 0);
#define SEAM(k) do { if (SEAMON(k)) { xcd_barrier(xbar, wave == 0 && lane_now() == 0); if ((k) == 0) grid.sync(); } } while (0)

    if (IN(0)) {
        const int lane = lane_now(), tid = wave * 64 + lane;
        if (bx < 192) mod_gemv_item(a, lds, bx, tid);
        LAS float* scr = (LAS float*)(lds + wave * 16384);
        constexpr int I_IN = (DM / 64) * (NINP / 32), I_UQ = (512 / 64) * (1536 / 32), I_UKV = (256 / 64) * (2048 / 32), I_BR = (1024 / 64) * (2048 / 32), I_OUT = (2048 / 64) * (2048 / 32);
        constexpr int NIT = I_IN + I_UQ + I_UKV + 2 * I_BR + I_OUT;
        for (int it = gw; it < NIT; it += NGW) { int r = it;
            if (r < I_IN) { transpose_item(a.w_in, DM, 10048, NINP, (bf16*)(a.ws + WS_WIN), scr, r, lane, 1, 1.f); continue; } r -= I_IN;
            if (r < I_UQ) { transpose_item(a.w_uq, 512, 1536, 1536, (bf16*)(a.ws + WS_WUQ), scr, r, lane, 2, QSCALE, a.q_norm); continue; } r -= I_UQ;
            if (r < I_UKV) { transpose_item(a.w_ukv, 256, 2048, 2048, (bf16*)(a.ws + WS_WUKV), scr, r, lane, 0, 1.f, a.kv_norm); continue; } r -= I_UKV;
            if (r < I_BR) { transpose_item(a.w_br_mla, 1024, 2048, 2048, (bf16*)(a.ws + WS_WBRA), scr, r, lane, 0, 1.f); continue; } r -= I_BR;
            if (r < I_BR) { transpose_item(a.w_br_hgrn, 1024, 2048, 2048, (bf16*)(a.ws + WS_WBRH), scr, r, lane, 0, 1.f); continue; } r -= I_BR;
            transpose_item(a.w_out, 2048, 2048, 2048, (bf16*)(a.ws + WS_WOUT), scr, r, lane, 0, 1.f); }
        float* RC = (float*)(a.ws + WS_ROPEC); float* RS = (float*)(a.ws + WS_ROPES);
        for (int i = bx * NTHR + tid; i < SEQ * 32; i += G * NTHR) { const int t = i >> 5, j = i & 31; const float pos = (float)(j < 16 ? (t >> 6) : (t & 63));
            const float inv = exp2f(-(float)(j & 15) * (13.287712379549449f / 16.f)); const float rev = pos * inv * 0.15915494309189535f;
            RC[i] = __builtin_amdgcn_cosf(rev); RS[i] = __builtin_amdgcn_sinf(rev); }
    }
    SEAM(0);
    if (IN(1)) { const int lane = lane_now(); for (int R = gw; R < MR; R += NGW) p1_row(a, R, lane); }
    SEAM(1);
    if (IN(2)) {
        pg8::Gemm g{(const bf16*)(a.ws + WS_H), (const bf16*)(a.ws + WS_WIN), MR, NINP, DM}; pg8::Order S; S.init(MR, NINP, G, bx, 0);
        pg8::EpiIn E{(bf16*)(a.ws + WS_CQ), (bf16*)(a.ws + WS_CKV), (bf16*)(a.ws + WS_KR), (bf16*)(a.ws + WS_HGQ), (bf16*)(a.ws + WS_HGFF), (bf16*)(a.ws + WS_HGFB), (bf16*)(a.ws + WS_HGI), (bf16*)(a.ws + WS_HGG), (bf16*)(a.ws + WS_GATE),
                     (unsigned long long*)(a.ws + WS_STAT + STAT_SQ), (unsigned long long*)(a.ws + WS_STAT + STAT_SQ) + MR, (const float*)(a.ws + WS_ROPEC), (const float*)(a.ws + WS_ROPES)};
        pg8::gemm_phase<pg8::EpiIn, pg8::Order, PG8_ALIGN, PG8_SP2>(lds, g, S, E, wave);
    }
    SEAM(2);
    if (IN(4)) {
        { pg8::Gemm g{(const bf16*)(a.ws + WS_CQ), (const bf16*)(a.ws + WS_WUQ), ML, 1536, 512}; pg8::Order S; S.init(ML, 1536, G, bx, 1);
          pg8::EpiQ E{(bf16*)(a.ws + WS_Q), (const float*)(a.ws + WS_ROPEC), (const float*)(a.ws + WS_ROPES), (const unsigned long long*)(a.ws + WS_STAT + STAT_SQ)};
          pg8::gemm_phase<pg8::EpiQ, pg8::Order, PG8_ALIGN, PG8_SP2>(lds, g, S, E, wave); }
        __syncthreads();
        { pg8::Gemm g{(const bf16*)(a.ws + WS_CKV), (const bf16*)(a.ws + WS_WUKV), MR, 2048, 256}; pg8::Order S; S.init(MR, 2048, G, bx, 0);
          pg8::EpiKV E{(bf16*)(a.ws + WS_KN), (bf16*)(a.ws + WS_VV), (const unsigned long long*)(a.ws + WS_STAT + STAT_SQ) + MR};
          pg8::gemm_phase<pg8::EpiKV, pg8::Order, PG8_ALIGN, PG8_SP2>(lds, g, S, E, wave); }
    }
    SEAM(4);
    if (IN(5)) {
        if (bx < 64) {
            hg::scan_unit(a, bx, lds, wave);
            asm volatile("s_waitcnt vmcnt(0)" ::: "memory"); __syncthreads();
            LAS unsigned* slot3 = (LAS unsigned*)(lds + LDS_MISC);
            if (wave == 0 && lane_now() == 0) { __builtin_amdgcn_fence(__ATOMIC_RELEASE, "agent"); asm volatile("s_waitcnt vmcnt(0)" ::: "memory");
                const unsigned old = __hip_atomic_fetch_add(ctl + 8 + (bx >> 1), 1u, __ATOMIC_RELAXED, __HIP_MEMORY_SCOPE_AGENT);
                __builtin_amdgcn_fence(__ATOMIC_ACQUIRE, "agent"); asm volatile("s_waitcnt vmcnt(0)" ::: "memory"); slot3[3] = old; }
            __syncthreads();
            if (slot3[3] == 1u) { const int lane = lane_now(), b = bx >> 4, h = (bx >> 1) & 7;
#pragma unroll 2
                for (int r0 = wave * 8; r0 < SEQ; r0 += 64) p6_part(a, b * SEQ + r0 + (lane >> 3), h * 128 + 16 * (lane & 7), lane & 7); }
        }
        __syncthreads();
        LAS unsigned* slot = (LAS unsigned*)(lds + LDS_MISC);
        for (;;) {
            if (wave == 0 && lane_now() == 0) slot[0] = __hip_atomic_fetch_add(ctl, 1u, __ATOMIC_RELAXED, __HIP_MEMORY_SCOPE_AGENT);
            __syncthreads();
            const unsigned u = slot[0];
            __syncthreads();
            if (u >= (unsigned)(NB * 8 * 32)) break;
            const int qb = u & 31, h = (u >> 5) & 7, b = u >> 8;
            const size_t R0 = (size_t)b * RB, m0 = (size_t)b * SEQ + qb * 256;
            att::attn_unit((const bf16*)(a.ws + WS_Q) + m0 * 1536 + h * 192, (const bf16*)(a.ws + WS_KN) + R0 * 1024 + h * 128, (const bf16*)(a.ws + WS_KR) + R0 * 64,
                           (const bf16*)(a.ws + WS_VV) + R0 * 1024 + h * 128, (bf16*)(a.ws + WS_ATTO) + m0 * 1024 + h * 128, RB, lds, wave);
        }
        __syncthreads();
        ffn_transpose_drain(a, lds, ctl + 2, wave);
    }
    SEAM(5);
    if (IN(6)) {
        ffn_transpose_drain(a, lds, ctl + 2, wave);
        __syncthreads();
        pg8::Gemm g{(const bf16*)(a.ws + WS_ATTO), (const bf16*)(a.ws + WS_WBRA), ML, DM, 1024}; pg8::Order S; S.init(ML, DM, G, bx, 0);
        pg8::EpiGate<false> E{(bf16*)(a.ws + WS_T), (const bf16*)(a.ws + WS_GATE), nullptr, 0, 0};
        pg8::gemm_phase<pg8::EpiGate<false>, pg8::Order, PG8_ALIGN, PG8_SP2>(lds, g, S, E, wave);
        asm volatile("s_waitcnt vmcnt(0)" ::: "memory"); __syncthreads();
    }
    if (IN(7)) {
        pg8::Gemm g{(const bf16*)(a.ws + WS_HGFF), (const bf16*)(a.ws + WS_WBRH), ML, DM, 1024}; pg8::Order S; S.init(ML, DM, G, bx, 1);
        pg8::EpiGate<true> E{(bf16*)(a.ws + WS_M1), (const bf16*)(a.ws + WS_GATE), (const bf16*)(a.ws + WS_T), 2048, 1};
        pg8::gemm_phase<pg8::EpiGate<true>, pg8::Order, PG8_ALIGN, PG8_SP2>(lds, g, S, E, wave);
    }
    SEAM(7);
    if (IN(8)) {
        unsigned long long* ST = (unsigned long long*)(a.ws + WS_STAT); unsigned* CN = (unsigned*)(a.ws + WS_STAT + 3 * 262144);
        pg8::Gemm g{(const bf16*)(a.ws + WS_M1), (const bf16*)(a.ws + WS_WOUT), ML, DM, DM}; pg8::OrderPanel S; S.init(G, bx);
        pg8::EpiRes1 E{a.x, a.out, (bf16*)(a.ws + WS_H2), (const float*)(a.ws + WS_MOD), a.norm_g, ST, ST + 32768, CN, CN + 128 * 64};
        pg8::gemm_phase<pg8::EpiRes1, pg8::OrderPanel, PG8_ALIGN, PG8_SP2>(lds, g, S, E, wave);
    }
    SEAM(8);
    if (IN(10)) {
        pg8::Gemm g{(const bf16*)(a.ws + WS_H2), (const bf16*)(a.ws + WS_WFIN), ML, 2 * DFF, DM}; pg8::Order S; S.init(ML, 2 * DFF, G, bx, 0);
        pg8::EpiSwiGLU E{(bf16*)(a.ws + WS_ACT)};
        pg8::gemm_phase<pg8::EpiSwiGLU, pg8::Order, PG8_ALIGN, PG8_SP2>(lds, g, S, E, wave);
    }
    SEAM(10);
    if (IN(11)) {
        unsigned long long* ST = (unsigned long long*)(a.ws + WS_STAT); unsigned* CN = (unsigned*)(a.ws + WS_STAT + 3 * 262144);
        pg8::Gemm g{(const bf16*)(a.ws + WS_ACT), (const bf16*)(a.ws + WS_WFOUT), ML, DM, DFF}; pg8::OrderPanel S; S.init(G, bx);
        pg8::EpiRes2 E{a.out, (const float*)(a.ws + WS_MOD), a.norm_g, ST + 2 * 32768, CN + 2 * 128 * 64};
        pg8::gemm_phase<pg8::EpiRes2, pg8::OrderPanel, PG8_ALIGN, PG8_SP2>(lds, g, S, E, wave);
    }
#ifdef PROBE_HI
    {
        const size_t offs[] = {PROBE_OFFS}; const size_t lens[] = {PROBE_LENS};
        constexpr int NBUF = sizeof(offs) / sizeof(offs[0]);
        for (size_t i = (size_t)bx * NTHR + wave * 64 + lane_now(); i < (size_t)ML * DM; i += (size_t)G * NTHR) { float acc = 0.f;
            for (int q = 0; q < NBUF; ++q) { const bf16* bp = (const bf16*)(a.ws + offs[q]); const float v = __uint_as_float((unsigned)bp[i % lens[q]] << 16); acc += (fabsf(v) < 1e30f) ? v : 1000.f; }
            a.out[i] = acc; }
    }
#endif
#undef IN
#undef SEAM
}

extern "C" void kernel_launch(void* const* d_in, const int* in_sizes, int n_in, void* d_out, int out_size, void* d_ws, size_t ws_size, hipStream_t stream) {
    static int grid = 0;
    if (grid == 0) {
        if (n_in != 19 || in_sizes[0] != ML * DM || out_size != ML * DM || ws_size < WS_END) { fprintf(stderr, "kernel_launch: shape/workspace mismatch (n_in %d, in0 %d, out %d, ws %zu < %zu)\n", n_in, n_in > 0 ? in_sizes[0] : -1, out_size, ws_size, (size_t)WS_END); grid = -1; return; }
        int dev = 0, cus = 0, per_cu = 0;
        if (hipGetDevice(&dev) != hipSuccess || hipDeviceGetAttribute(&cus, hipDeviceAttributeMultiprocessorCount, dev) != hipSuccess) { grid = -1; return; }
        if (hipFuncSetAttribute((const void*)fwd_megakernel, hipFuncAttributeMaxDynamicSharedMemorySize, LDS_BYTES) != hipSuccess) { fprintf(stderr, "kernel_launch: hipFuncSetAttribute failed\n"); grid = -1; return; }
        if (hipOccupancyMaxActiveBlocksPerMultiprocessor(&per_cu, (const void*)fwd_megakernel, NTHR, LDS_BYTES) != hipSuccess || per_cu < 1) { fprintf(stderr, "kernel_launch: occupancy query gave %d\n", per_cu); per_cu = 1; }
        (void)hipGetLastError();
        grid = cus * per_cu;
    }
    if (grid < 0) return;
    Args a{};
    const float** p = (const float**)&a;
    for (int i = 0; i < 19; ++i) p[i] = (const float*)d_in[i];
    a.out = (float*)d_out; a.ws = (unsigned char*)d_ws; a.ph_lo = 0; a.ph_hi = 13;

    if (hipMemsetAsync((char*)d_ws + WS_CTL, 0, WS_STAT + STAT_BYTES, stream) != hipSuccess) { fprintf(stderr, "kernel_launch: memset failed\n"); return; }
    void* args[] = {&a};
    hipError_t e = hipLaunchCooperativeKernel((const void*)fwd_megakernel, dim3(grid), dim3(NTHR), args, LDS_BYTES, stream);
    if (e != hipSuccess) fprintf(stderr, "cooperative launch failed: %s (grid %d)\n", hipGetErrorString(e), grid);
}
```
